# Optimizing an MI355X kernel written in HIP

```python
import jax, jax.numpy as jnp
from jax import lax
import numpy as np

D_MODEL = 2048
BATCH = 4
SEQ = 4096
DEPTH = 1

N_HEADS_MLA = 8
Q_LORA_RANK = 512
KV_LORA_RANK = 512
QK_NOPE_DIM = 128
QK_ROPE_DIM = 64
QK_HEAD_DIM = QK_NOPE_DIM + QK_ROPE_DIM
V_HEAD_DIM = 128
MLA_WIDTH = N_HEADS_MLA * V_HEAD_DIM
N_HEADS_SB = 8
SB_HEAD_DIM = 128
SB_WIDTH = N_HEADS_SB * SB_HEAD_DIM
D_FF = -(-8 * D_MODEL // (3 * 256)) * 256
D_IN = Q_LORA_RANK + KV_LORA_RANK + QK_ROPE_DIM + 3 * SB_WIDTH + 2 * D_MODEL
Q_BLOCK = 128
ROPE_THETA = 10000.0
EPS = 1e-6

kernel_name = "hybrid_mla_stickbreaking_gated_block"


def _rms(x, g):
    xf = x.astype(jnp.float32)
    y = xf * lax.rsqrt(jnp.mean(xf * xf, axis=-1, keepdims=True) + EPS)
    return (y * g.astype(jnp.float32)).astype(x.dtype)


def _rope(x, pos):
    half = x.shape[-1] // 2
    freqs = ROPE_THETA ** (-jnp.arange(half, dtype=jnp.float32) / half)
    ang = pos.astype(jnp.float32)[..., None] * freqs
    cos = jnp.cos(ang)[:, :, None, :]
    sin = jnp.sin(ang)[:, :, None, :]
    xf = x.astype(jnp.float32)
    x1, x2 = xf[..., :half], xf[..., half:]
    return jnp.concatenate([x1 * cos - x2 * sin, x1 * sin + x2 * cos], axis=-1).astype(x.dtype)


def _mla_attention(q, k, v):
    S = q.shape[2]
    scale = QK_HEAD_DIM ** -0.5
    outs = []
    for i in range(S // Q_BLOCK):
        end = (i + 1) * Q_BLOCK
        qb = q[:, :, i * Q_BLOCK:end]
        s = jnp.einsum('bhqd,bhkd->bhqk', qb, k[:, :, :end]).astype(jnp.float32) * scale
        qi = i * Q_BLOCK + jnp.arange(Q_BLOCK)
        ki = jnp.arange(end)
        s = jnp.where(ki[None, :] <= qi[:, None], s, -jnp.inf)
        p = jax.nn.softmax(s, axis=-1).astype(v.dtype)
        outs.append(jnp.einsum('bhqk,bhkd->bhqd', p, v[:, :, :end]))
    return jnp.concatenate(outs, axis=2)


def _stick_breaking(q, k, v):
    S = q.shape[2]
    scale = SB_HEAD_DIM ** -0.5
    outs = []
    for i in range(S // Q_BLOCK):
        end = (i + 1) * Q_BLOCK
        qb = q[:, :, i * Q_BLOCK:end]
        z = jnp.einsum('bhqd,bhkd->bhqk', qb, k[:, :, :end]).astype(jnp.float32) * scale
        qi = i * Q_BLOCK + jnp.arange(Q_BLOCK)
        ki = jnp.arange(end)
        mask = ki[None, :] < qi[:, None]
        log_beta = jax.nn.log_sigmoid(z)
        log_one_minus = jnp.where(mask, jax.nn.log_sigmoid(-z), 0.0)
        tail = lax.cumsum(log_one_minus, axis=3, reverse=True) - log_one_minus
        a = jnp.where(mask, jnp.exp(log_beta + tail), 0.0).astype(v.dtype)
        outs.append(jnp.einsum('bhqk,bhkd->bhqd', a, v[:, :, :end]))
    return jnp.concatenate(outs, axis=2)


def _layer(x, c_act, pos, w_ada, b_ada, g_norm1, g_norm2, w_in, g_q_latent, g_kv_latent,
           w_uq, w_ukv, g_q_head, g_k_head, w_proj_mla, w_proj_sb, w_out, w_ffn_in, w_ffn_out):
    B, S, _ = x.shape
    ada = (c_act @ w_ada + b_ada)[:, None, :]
    sh1, sc1, gt1, sh2, sc2, gt2 = jnp.split(ada, 6, axis=-1)

    h = _rms(x, g_norm1) * (1 + sc1) + sh1
    proj = h @ w_in
    offs = np.cumsum([Q_LORA_RANK, KV_LORA_RANK, QK_ROPE_DIM, SB_WIDTH, SB_WIDTH, SB_WIDTH, D_MODEL])
    c_q, c_kv, k_pe, q_sb, k_sb, v_sb, gl_a, gl_b = jnp.split(proj, [int(o) for o in offs], axis=-1)

    q = (_rms(c_q, g_q_latent) @ w_uq).reshape(B, S, N_HEADS_MLA, QK_HEAD_DIM)
    kv = (_rms(c_kv, g_kv_latent) @ w_ukv).reshape(B, S, N_HEADS_MLA, QK_NOPE_DIM + V_HEAD_DIM)
    k_nope, v = kv[..., :QK_NOPE_DIM], kv[..., QK_NOPE_DIM:]
    k_pe_h = jnp.broadcast_to(k_pe[:, :, None, :], (B, S, N_HEADS_MLA, QK_ROPE_DIM))
    k = jnp.concatenate([k_nope, k_pe_h], axis=-1)
    q = _rms(q, g_q_head)
    k = _rms(k, g_k_head)
    q = jnp.concatenate([q[..., :QK_NOPE_DIM], _rope(q[..., QK_NOPE_DIM:], pos)], axis=-1)
    k = jnp.concatenate([k[..., :QK_NOPE_DIM], _rope(k[..., QK_NOPE_DIM:], pos)], axis=-1)
    y_a = _mla_attention(q.transpose(0, 2, 1, 3), k.transpose(0, 2, 1, 3), v.transpose(0, 2, 1, 3))
    y_a = y_a.transpose(0, 2, 1, 3).reshape(B, S, MLA_WIDTH)

    to_heads = lambda t: t.reshape(B, S, N_HEADS_SB, SB_HEAD_DIM).transpose(0, 2, 1, 3)
    y_b = _stick_breaking(to_heads(q_sb), to_heads(k_sb), to_heads(v_sb))
    y_b = y_b.transpose(0, 2, 1, 3).reshape(B, S, SB_WIDTH)

    merged = jax.nn.sigmoid(gl_a) * (y_a @ w_proj_mla) + jax.nn.sigmoid(gl_b) * (y_b @ w_proj_sb)
    x = x + gt1 * (merged @ w_out)

    h2 = _rms(x, g_norm2) * (1 + sc2) + sh2
    gate, up = jnp.split(h2 @ w_ffn_in, 2, axis=-1)
    x = x + gt2 * ((jax.nn.silu(gate) * up) @ w_ffn_out)
    return x


def setup_inputs(seed: int = 0) -> dict:
    key = jax.random.key(seed)
    ks = jax.random.split(key, 24)
    f32 = jnp.float32

    def nrm(k, shape, fan_in):
        return jax.random.normal(k, shape, f32) * (fan_in ** -0.5)

    def gain(k, n):
        return 1.0 + 0.02 * jax.random.normal(k, (DEPTH, n), f32)

    x = jax.random.normal(ks[0], (BATCH, SEQ, D_MODEL), f32)
    c = jax.random.normal(ks[1], (BATCH, D_MODEL), f32)
    offset = jax.random.randint(ks[2], (BATCH, 1), 0, 1024, dtype=jnp.int32)
    positions = offset + jnp.arange(SEQ, dtype=jnp.int32)[None, :]
    return {
        "x": x,
        "c": c,
        "positions": positions,
        "w_ada": nrm(ks[3], (DEPTH, D_MODEL, 6 * D_MODEL), D_MODEL),
        "b_ada": 0.02 * jax.random.normal(ks[4], (DEPTH, 6 * D_MODEL), f32),
        "g_norm1": gain(ks[5], D_MODEL),
        "g_norm2": gain(ks[6], D_MODEL),
        "w_in": nrm(ks[7], (DEPTH, D_MODEL, D_IN), D_MODEL),
        "g_q_latent": gain(ks[8], Q_LORA_RANK),
        "g_kv_latent": gain(ks[9], KV_LORA_RANK),
        "w_uq": nrm(ks[10], (DEPTH, Q_LORA_RANK, N_HEADS_MLA * QK_HEAD_DIM), Q_LORA_RANK),
        "w_ukv": nrm(ks[11], (DEPTH, KV_LORA_RANK, N_HEADS_MLA * (QK_NOPE_DIM + V_HEAD_DIM)), KV_LORA_RANK),
        "g_q_head": gain(ks[12], QK_HEAD_DIM),
        "g_k_head": gain(ks[13], QK_HEAD_DIM),
        "w_proj_mla": nrm(ks[14], (DEPTH, MLA_WIDTH, D_MODEL), MLA_WIDTH),
        "w_proj_sb": nrm(ks[15], (DEPTH, SB_WIDTH, D_MODEL), SB_WIDTH),
        "w_out": nrm(ks[16], (DEPTH, D_MODEL, D_MODEL), D_MODEL),
        "w_ffn_in": nrm(ks[17], (DEPTH, D_MODEL, 2 * D_FF), D_MODEL),
        "w_ffn_out": nrm(ks[18], (DEPTH, D_FF, D_MODEL), D_FF),
    }


def reference(x, c, positions, w_ada, b_ada, g_norm1, g_norm2, w_in, g_q_latent, g_kv_latent,
              w_uq, w_ukv, g_q_head, g_k_head, w_proj_mla, w_proj_sb, w_out, w_ffn_in, w_ffn_out):
    c_act = jax.nn.silu(c)
    for l in range(DEPTH):
        x = _layer(x, c_act, positions, w_ada[l], b_ada[l], g_norm1[l], g_norm2[l], w_in[l],
                   g_q_latent[l], g_kv_latent[l], w_uq[l], w_ukv[l], g_q_head[l], g_k_head[l],
                   w_proj_mla[l], w_proj_sb[l], w_out[l], w_ffn_in[l], w_ffn_out[l])
    return x
```

```cpp
#include <hip/hip_runtime.h>
#include <hip/hip_cooperative_groups.h>
#include <cstdio>
#include <cstdint>
namespace cg = cooperative_groups;

#define LAS __attribute__((address_space(3)))
typedef unsigned short bf16;
typedef short bf16x8 __attribute__((ext_vector_type(8)));
typedef short s16x4 __attribute__((ext_vector_type(4)));
typedef float f32x2 __attribute__((ext_vector_type(2)));
typedef float f32x4 __attribute__((ext_vector_type(4)));
typedef float f32x16 __attribute__((ext_vector_type(16)));
typedef unsigned u32x4 __attribute__((ext_vector_type(4)));
typedef unsigned u32x2 __attribute__((ext_vector_type(2)));
typedef __bf16 bf16x2_t __attribute__((ext_vector_type(2)));

constexpr int NB = 4, SEQ = 4096, T = NB * SEQ, DM = 2048;
constexpr int NH = 8, DQK = 192, DFF = 5632, DIN = 8256, PLD = 8448;
constexpr int C_KPE = 1024, C_SBQ = 1280, C_SBK = 2304, C_SBV = 3328, C_GA = 4352, C_GB = 6400;
constexpr int ADA_N = 6 * DM;
constexpr int NPART = 32;
constexpr float EPS = 1e-6f;
constexpr size_t MiB = 1u << 20;
constexpr size_t WS_ADA = 0;
constexpr size_t WS_WIN = 1 * MiB, WS_WUQ = 34 * MiB, WS_WUKV = 36 * MiB, WS_WPA = 38 * MiB, WS_WPB = 42 * MiB, WS_WOUT = 46 * MiB, WS_WFI = 54 * MiB, WS_WFO = 98 * MiB;
constexpr size_t WS_PROJ = 120 * MiB;
constexpr size_t WS_KVRAW = 384 * MiB;
constexpr size_t WS_Y = 448 * MiB;
constexpr size_t WS_END = 512 * MiB;
constexpr size_t DO_K = 48 * MiB;

__device__ const float ROPE_FREQ[32] = {1.0f, 0.7498942613601685f, 0.5623413324356079f, 0.4216965138912201f, 0.3162277638912201f, 0.23713737726211548f, 0.17782793939113617f, 0.133352130651474f,
    0.10000000149011612f, 0.07498941570520401f, 0.05623413249850273f, 0.04216965287923813f, 0.03162277489900589f, 0.023713737726211548f, 0.017782794311642647f, 0.01333521492779255f,
    0.009999999776482582f, 0.007498941849917173f, 0.005623413249850273f, 0.0042169648222625256f, 0.003162277629598975f, 0.00237137358635664f, 0.0017782794311642647f, 0.0013335214462131262f,
    0.0010000000474974513f, 0.0007498942431993783f, 0.000562341301701963f, 0.0004216965171508491f, 0.0003162277571391314f, 0.00023713737027719617f, 0.00017782794020604342f, 0.0001333521504420787f};

__device__ __forceinline__ unsigned cvt_pk(float lo, float hi) { f32x2 v = {lo, hi}; bf16x2_t b = __builtin_convertvector(v, bf16x2_t); return __builtin_bit_cast(unsigned, b); }
__device__ __forceinline__ float bf_lo(unsigned u) { return __uint_as_float(u << 16); }
__device__ __forceinline__ float bf_hi(unsigned u) { return __uint_as_float(u & 0xffff0000u); }
__device__ __forceinline__ float bf2f(bf16 b) { return __uint_as_float((unsigned)b << 16); }
__device__ __forceinline__ bf16 f2bf(float f) { return (bf16)(cvt_pk(f, 0.f) & 0xffffu); }
__device__ __forceinline__ float wave_sum(float v) {
#pragma unroll
    for (int o = 1; o < 64; o <<= 1) v += __shfl_xor(v, o);
    return v;
}
__device__ __forceinline__ float fast_sigmoid(float x) { return __builtin_amdgcn_rcpf(1.0f + __expf(-x)); }

namespace pg8 {
constexpr int BM = 256, BK = 64, HALF = 128, HTB = HALF * BK * 2, STAGE_BYTES = 8 * HTB, NXCD = 8, WGM = 8;
__host__ __device__ __forceinline__ int lds_byte(int r, int c) { const int st = (r >> 4) * 2 + (c >> 5), rr = r & 15, cc = c & 31, ob = rr * 64 + cc * 2; return st * 1024 + (ob ^ (((ob >> 9) & 1) << 5)); }
__host__ __device__ __forceinline__ void stage_rc(int b, int& R, int& C) { const int st = b / 1024, sb = b % 1024, swz = sb ^ (((sb >> 9) & 1) << 5); R = (st >> 1) * 16 + swz / 64; C = (st & 1) * 32 + (swz % 64) / 2; }
__host__ __device__ __forceinline__ int perm32(int rho) { const int n = rho >> 4, i = rho & 15; return 8 * (i >> 2) + 4 * n + (i & 3); }
struct Unit { int pm, pn; };
struct Gemm { const bf16* A; const bf16* Bt; int M, N, K, lda, ldb; };
struct StaticOrder {
    int nM, nN, nwg, G, c;
    __device__ void init(int M, int N, int G_, int c_) { nM = M / BM; nN = N / BM; nwg = nM * nN; G = G_; c = c_; }
    __device__ bool next(int i, Unit& u) const {
        const long L = (long)i * G + c; if (L >= nwg) return false;
        int wgid = (int)L; { const int q = nwg / NXCD, r = nwg % NXCD, xcd = wgid % NXCD, off = wgid / NXCD; wgid = (xcd < r ? xcd * (q + 1) : r * (q + 1) + (xcd - r) * q) + off; }
        const int nig = WGM * nN, gid = wgid / nig, fm = gid * WGM, gsz = (nM - fm) < WGM ? (nM - fm) : WGM;
        u.pm = fm + ((wgid % nig) % gsz); u.pn = (wgid % nig) / gsz; return true;
    }
};
typedef f32x4 Acc[2][2][4][2];

struct EpiBf16 {
    bf16* O; int ldc;
    __device__ __forceinline__ void operator()(const Acc& acc, const Unit& u, int wr, int wc, int fr, int fq) const {
        const int row0 = u.pm * BM + wr * 64 + fr, col0 = u.pn * BM + wc * 32 + 8 * fq;
#pragma unroll
        for (int ai = 0; ai < 2; ++ai)
#pragma unroll
            for (int m = 0; m < 4; ++m) { bf16* rowp = O + (size_t)(row0 + ai * HALF + m * 16) * ldc + col0;
#pragma unroll
                for (int bj = 0; bj < 2; ++bj) { const f32x4 v0 = acc[ai][bj][m][0], v1 = acc[ai][bj][m][1];
                    u32x4 w; w.x = cvt_pk(v0[0], v0[1]); w.y = cvt_pk(v0[2], v0[3]); w.z = cvt_pk(v1[0], v1[1]); w.w = cvt_pk(v1[2], v1[3]);
                    *(u32x4*)(rowp + bj * HALF) = w; } }
    }
};
template <bool ACCUM> struct EpiGate {
    bf16* O; int ldc; const bf16* gate; int ldg;
    __device__ __forceinline__ void operator()(const Acc& acc, const Unit& u, int wr, int wc, int fr, int fq) const {
        const int row0 = u.pm * BM + wr * 64 + fr, col0 = u.pn * BM + wc * 32 + 8 * fq;
#pragma unroll
        for (int ai = 0; ai < 2; ++ai)
#pragma unroll
            for (int m = 0; m < 4; ++m) { const size_t row = (size_t)(row0 + ai * HALF + m * 16);
#pragma unroll
                for (int bj = 0; bj < 2; ++bj) {
                    const u32x4 g = *(const u32x4*)(gate + row * ldg + col0 + bj * HALF);
                    const f32x4 v0 = acc[ai][bj][m][0], v1 = acc[ai][bj][m][1];
                    float r[8];
                    r[0] = v0[0] * fast_sigmoid(bf_lo(g.x)); r[1] = v0[1] * fast_sigmoid(bf_hi(g.x)); r[2] = v0[2] * fast_sigmoid(bf_lo(g.y)); r[3] = v0[3] * fast_sigmoid(bf_hi(g.y));
                    r[4] = v1[0] * fast_sigmoid(bf_lo(g.z)); r[5] = v1[1] * fast_sigmoid(bf_hi(g.z)); r[6] = v1[2] * fast_sigmoid(bf_lo(g.w)); r[7] = v1[3] * fast_sigmoid(bf_hi(g.w));
                    bf16* op = O + row * ldc + col0 + bj * HALF;
                    if (ACCUM) { const u32x4 o = *(const u32x4*)op;
                        r[0] += bf_lo(o.x); r[1] += bf_hi(o.x); r[2] += bf_lo(o.y); r[3] += bf_hi(o.y); r[4] += bf_lo(o.z); r[5] += bf_hi(o.z); r[6] += bf_lo(o.w); r[7] += bf_hi(o.w); }
                    u32x4 w; w.x = cvt_pk(r[0], r[1]); w.y = cvt_pk(r[2], r[3]); w.z = cvt_pk(r[4], r[5]); w.w = cvt_pk(r[6], r[7]);
                    *(u32x4*)op = w; } }
    }
};
struct EpiRes {
    const float* base; float* out; const float* gt; int gt_ld;
    __device__ __forceinline__ void operator()(const Acc& acc, const Unit& u, int wr, int wc, int fr, int fq) const {
        const int row0 = u.pm * BM + wr * 64 + fr, col0 = u.pn * BM + wc * 32 + 8 * fq;
        const float* gp = gt + (size_t)((u.pm * BM) / SEQ) * gt_ld + col0;
        f32x4 gv[2][2];
#pragma unroll
        for (int bj = 0; bj < 2; ++bj)
#pragma unroll
            for (int n = 0; n < 2; ++n) gv[bj][n] = *(const f32x4*)(gp + bj * HALF + 4 * n);
#pragma unroll
        for (int ai = 0; ai < 2; ++ai)
#pragma unroll
            for (int m = 0; m < 4; ++m) { const size_t off = (size_t)(row0 + ai * HALF + m * 16) * DM + col0;
#pragma unroll
                for (int bj = 0; bj < 2; ++bj)
#pragma unroll
                    for (int n = 0; n < 2; ++n) { const f32x4 b = *(const f32x4*)(base + off + bj * HALF + 4 * n);
                        *(f32x4*)(out + off + bj * HALF + 4 * n) = b + gv[bj][n] * acc[ai][bj][m][n]; } }
    }
};
struct EpiSwiglu {
    bf16* O; int ldc;
    __device__ __forceinline__ void operator()(const Acc& acc, const Unit& u, int wr, int wc, int fr, int fq) const {
        const int row0 = u.pm * BM + wr * 64 + fr, col0 = u.pn * HALF + wc * 32 + 8 * fq;
#pragma unroll
        for (int ai = 0; ai < 2; ++ai)
#pragma unroll
            for (int m = 0; m < 4; ++m) { float r[8];
#pragma unroll
                for (int n = 0; n < 2; ++n)
#pragma unroll
                    for (int e = 0; e < 4; ++e) { const float g = acc[ai][0][m][n][e], up = acc[ai][1][m][n][e]; r[4 * n + e] = g * fast_sigmoid(g) * up; }
                u32x4 w; w.x = cvt_pk(r[0], r[1]); w.y = cvt_pk(r[2], r[3]); w.z = cvt_pk(r[4], r[5]); w.w = cvt_pk(r[6], r[7]);
                *(u32x4*)(O + (size_t)(row0 + ai * HALF + m * 16) * ldc + col0) = w; }
    }
};

template <class Epi>
__device__ __forceinline__ void gemm_phase(LAS unsigned char* lds, const Gemm g, const StaticOrder& S, const Epi& E) {
    int tid = threadIdx.x;
    asm volatile("" : "+v"(tid));
    const int wid = __builtin_amdgcn_readfirstlane(tid >> 6), lane = tid & 63, wr = wid >> 2, wc = wid & 3, fr = lane & 15, fq = lane >> 4;
    const int K = g.K, nt = K / BK;
    unsigned voffA[2], voffB[2];
#pragma unroll
    for (int i = 0; i < 2; ++i) { int R, C; stage_rc(tid * 16 + i * 8192, R, C); const int Rb = (R & ~31) + perm32(R & 31);
        voffA[i] = (unsigned)(R * g.lda + C) * 2u; voffB[i] = (unsigned)(Rb * g.ldb + C) * 2u; }
    const size_t kstep = (size_t)(BK * 2);
    const size_t hstepA = (size_t)HALF * g.lda * 2, hstepB = (size_t)HALF * g.ldb * 2;
    const size_t tstepA = 2 * hstepA, tstepB = 2 * hstepB;
    const unsigned ldsw = (unsigned)wid * 1024u;
    const int aoff = lds_byte(wr * 64 + fr, fq * 8), boff = lds_byte(wc * 32 + fr, fq * 8);
#define PG8_SA(b, h) (((b) * 2 + (h)) * HTB)
#define PG8_SB(b, h) ((4 + (b) * 2 + (h)) * HTB)
#define PG8_STAGE(bufoff, gbase, voff) do { _Pragma("unroll") for (int _i = 0; _i < 2; ++_i) \
        __builtin_amdgcn_global_load_lds((const unsigned*)((const char*)(gbase) + (voff)[_i]), (LAS unsigned*)(lds + (bufoff) + ldsw + _i * 8192), 16, 0, 0); } while (0)
#define PG8_LDA(dst, b, h) do { _Pragma("unroll") for (int m = 0; m < 4; ++m) _Pragma("unroll") for (int k = 0; k < 2; ++k) dst[m][k] = *(const LAS bf16x8*)(lds + PG8_SA(b, h) + aoff + m * 2048 + k * 1024); } while (0)
#define PG8_LDB(dst, b, h) do { _Pragma("unroll") for (int n = 0; n < 2; ++n) _Pragma("unroll") for (int k = 0; k < 2; ++k) dst[n][k] = *(const LAS bf16x8*)(lds + PG8_SB(b, h) + boff + n * 2048 + k * 1024); } while (0)
#define PG8_MMA(ai, bj, At, Bt) do { __builtin_amdgcn_s_setprio(1); _Pragma("unroll") for (int m = 0; m < 4; ++m) _Pragma("unroll") for (int n = 0; n < 2; ++n) _Pragma("unroll") for (int k = 0; k < 2; ++k) \
        acc[ai][bj][m][n] = __builtin_amdgcn_mfma_f32_16x16x32_bf16(Bt[n][k], At[m][k], acc[ai][bj][m][n], 0, 0, 0); __builtin_amdgcn_s_setprio(0); } while (0)
#define PG8_WAIT_V(n) asm volatile("s_waitcnt vmcnt(" #n ")" ::: "memory")
#define PG8_WAIT_L(n) asm volatile("s_waitcnt lgkmcnt(" #n ")" ::: "memory")
#define PG8_BAR __builtin_amdgcn_s_barrier()
#define PG8_SCHED __builtin_amdgcn_sched_barrier(0)
    Unit cur, nxt; int ui = 0;
    if (!S.next(0, cur)) return;
    Acc acc;
#pragma unroll
    for (int a = 0; a < 2; ++a)
#pragma unroll
        for (int b = 0; b < 2; ++b)
#pragma unroll
            for (int m = 0; m < 4; ++m)
#pragma unroll
                for (int n = 0; n < 2; ++n) acc[a][b][m][n] = (f32x4){0.f, 0.f, 0.f, 0.f};
    bf16x8 At[4][2], B0[2][2], B1[2][2];
    const char* cA = (const char*)g.A + (size_t)cur.pm * tstepA; const char* cB = (const char*)g.Bt + (size_t)cur.pn * tstepB;
    PG8_STAGE(PG8_SB(0, 0), cB, voffB); PG8_STAGE(PG8_SB(0, 1), cB + hstepB, voffB); PG8_STAGE(PG8_SA(0, 0), cA, voffA); PG8_STAGE(PG8_SA(0, 1), cA + hstepA, voffA);
    if (wr == 1) PG8_BAR;
    PG8_WAIT_V(2); PG8_BAR;
    PG8_STAGE(PG8_SB(1, 0), cB + kstep, voffB); PG8_STAGE(PG8_SA(1, 0), cA + kstep, voffA); PG8_STAGE(PG8_SB(1, 1), cB + hstepB + kstep, voffB);
    PG8_WAIT_V(6); PG8_BAR;
    for (;;) {
        const bool has_next = S.next(ui + 1, nxt);
        const char* nA = has_next ? (const char*)g.A + (size_t)nxt.pm * tstepA : cA; const char* nB = has_next ? (const char*)g.Bt + (size_t)nxt.pn * tstepB : cB;
        for (int t = 0; t < nt; t += 2) {
            const bool last = (t == nt - 2);
            const char* a1 = cA + (size_t)(t + 1) * kstep;
            const char* a2 = last ? nA : cA + (size_t)(t + 2) * kstep; const char* b2 = last ? nB : cB + (size_t)(t + 2) * kstep;
            const char* a3 = a2 + kstep; const char* b3 = b2 + kstep;
            PG8_LDB(B0, 0, 0); PG8_LDB(B1, 0, 1); PG8_SCHED; PG8_LDA(At, 0, 0); PG8_STAGE(PG8_SA(1, 1), a1 + hstepA, voffA);
            PG8_WAIT_V(8); PG8_WAIT_L(0); PG8_BAR; PG8_MMA(0, 0, At, B0); PG8_MMA(0, 1, At, B1); PG8_BAR; PG8_SCHED;
            PG8_LDA(At, 0, 1); PG8_STAGE(PG8_SB(0, 0), b2, voffB); PG8_STAGE(PG8_SB(0, 1), b2 + hstepB, voffB); PG8_STAGE(PG8_SA(0, 0), a2, voffA);
            PG8_WAIT_V(8); PG8_WAIT_L(0); PG8_BAR; PG8_MMA(1, 0, At, B0); PG8_MMA(1, 1, At, B1); PG8_BAR; PG8_SCHED;
            PG8_LDB(B0, 1, 0); PG8_LDB(B1, 1, 1); PG8_SCHED; PG8_LDA(At, 1, 0); PG8_STAGE(PG8_SA(0, 1), a2 + hstepA, voffA);
            PG8_WAIT_V(8); PG8_WAIT_L(0); PG8_BAR; PG8_MMA(0, 0, At, B0); PG8_MMA(0, 1, At, B1); PG8_BAR; PG8_SCHED;
            PG8_LDA(At, 1, 1); PG8_STAGE(PG8_SB(1, 0), b3, voffB); PG8_STAGE(PG8_SB(1, 1), b3 + hstepB, voffB); PG8_STAGE(PG8_SA(1, 0), a3, voffA);
            PG8_WAIT_V(8); PG8_WAIT_L(0); PG8_BAR; PG8_MMA(1, 0, At, B0); PG8_MMA(1, 1, At, B1); PG8_BAR; PG8_SCHED;
        }
        if (wr == 0) PG8_BAR;
        E(acc, cur, wr, wc, fr, fq);
        if (!has_next) break;
#pragma unroll
        for (int a = 0; a < 2; ++a)
#pragma unroll
            for (int b = 0; b < 2; ++b)
#pragma unroll
                for (int m = 0; m < 4; ++m)
#pragma unroll
                    for (int n = 0; n < 2; ++n) acc[a][b][m][n] = (f32x4){0.f, 0.f, 0.f, 0.f};
        cur = nxt; cA = nA; cB = nB; ++ui;
        if (wr == 1) PG8_BAR;
    }
    PG8_WAIT_V(0);
    PG8_BAR;
#undef PG8_SA
#undef PG8_SB
#undef PG8_STAGE
#undef PG8_LDA
#undef PG8_LDB
#undef PG8_MMA
#undef PG8_WAIT_V
#undef PG8_WAIT_L
#undef PG8_BAR
#undef PG8_SCHED
}
}

__device__ __forceinline__ int crow(int r, int hi) { return (r & 3) + 8 * (r >> 2) + 4 * hi; }
__device__ __forceinline__ s16x4 vtr(const LAS unsigned char* p) { typedef short v4i16_t __attribute__((ext_vector_type(4)));
    return __builtin_bit_cast(s16x4, __builtin_amdgcn_ds_read_tr16_b64_v4i16((LAS v4i16_t*)p)); }
constexpr int AT_K0 = 0, AT_K1 = 25600, AT_V0 = 51200, AT_V1 = 71680, AT_VROW = 320;

template <bool SBK>
__device__ __forceinline__ void attn_unit(LAS unsigned char* lds, const bf16* __restrict__ Qp, int ldq, const bf16* __restrict__ Kp, int ldk,
                                          const bf16* __restrict__ Vp, int ldv, bf16* __restrict__ Op, int ldo, int q0, int tid, int wave, int lane) {
    constexpr int DK = SBK ? 128 : 192, NST = DK / 16, KROW = DK * 2 + 16, KCH = DK / 8, NKI = (64 * KCH) / 512;
    asm volatile("" : "+v"(tid), "+v"(lane));
    const int ql = lane & 31, hi = lane >> 5, qw0 = q0 + 32 * wave, myq = qw0 + ql;
    const int nt = (q0 + 256) / 64;
    bf16x8 qf[NST];
    { const bf16* qrow = Qp + (size_t)myq * ldq + 8 * hi;
#pragma unroll
      for (int st = 0; st < NST; ++st) qf[st] = *(const bf16x8*)(qrow + 16 * st); }
    unsigned kgo[NKI], kls[NKI], vgo[2], vls[2];
#pragma unroll
    for (int i = 0; i < NKI; ++i) { const int c = tid + 512 * i, row = c / KCH, cc = c % KCH; kgo[i] = (unsigned)(row * ldk + cc * 8); kls[i] = (unsigned)(row * KROW + cc * 16); }
#pragma unroll
    for (int i = 0; i < 2; ++i) { const int c = tid + 512 * i, row = c >> 4, cc = c & 15; vgo[i] = (unsigned)(row * ldv + cc * 8); vls[i] = (unsigned)(row * AT_VROW + cc * 16); }
    u32x4 kr[NKI], vr[2];
#define AT_LOAD(j) do { const bf16* kp_ = Kp + (size_t)(64 * (j)) * ldk; const bf16* vp_ = Vp + (size_t)(64 * (j)) * ldv; \
        _Pragma("unroll") for (int i = 0; i < NKI; ++i) kr[i] = *(const u32x4*)(kp_ + kgo[i]); \
        _Pragma("unroll") for (int i = 0; i < 2; ++i) vr[i] = *(const u32x4*)(vp_ + vgo[i]); } while (0)
#define AT_STORE(b) do { LAS unsigned char* kb_ = lds + ((b) ? AT_K1 : AT_K0); LAS unsigned char* vb_ = lds + ((b) ? AT_V1 : AT_V0); \
        _Pragma("unroll") for (int i = 0; i < NKI; ++i) *(LAS u32x4*)(kb_ + kls[i]) = kr[i]; \
        _Pragma("unroll") for (int i = 0; i < 2; ++i) *(LAS u32x4*)(vb_ + vls[i]) = vr[i]; } while (0)
    f32x16 o[4];
#pragma unroll
    for (int d = 0; d < 4; ++d)
#pragma unroll
        for (int i = 0; i < 16; ++i) o[d][i] = 0.f;
    float m_run = -INFINITY, l_run = 0.f, carry = 0.f;
    const float qk_scale = SBK ? 0.08838834764831845f : 0.07216878364870323f;
    const float c2 = qk_scale * 1.4426950408889634f;
    const unsigned koff = (unsigned)(ql * KROW + hi * 16);
    const unsigned voff = (unsigned)((4 * hi + ((lane >> 2) & 3)) * AT_VROW + (16 * ((lane >> 4) & 1) + 4 * (lane & 3)) * 2);

    __syncthreads();
    { const int j0 = SBK ? nt - 1 : 0; AT_LOAD(j0); AT_STORE(0); }
    __syncthreads();
#pragma unroll 1
    for (int jj = 0; jj < nt; ++jj) {
        const int j = SBK ? nt - 1 - jj : jj, k0 = 64 * j, b = jj & 1;
        const bool more = (jj + 1 < nt);
        if (more) { const int jn = SBK ? j - 1 : j + 1; AT_LOAD(jn); }
        const bool active = SBK ? (k0 < qw0 + 31) : (k0 <= qw0 + 31);
        if (active) {
            const LAS unsigned char* kb = lds + (b ? AT_K1 : AT_K0) + koff;
            f32x16 s0, s1;
#pragma unroll
            for (int i = 0; i < 16; ++i) { s0[i] = 0.f; s1[i] = 0.f; }
#pragma unroll
            for (int st = 0; st < NST; ++st) {
                const bf16x8 a0 = *(const LAS bf16x8*)(kb + st * 32), a1 = *(const LAS bf16x8*)(kb + 32 * KROW + st * 32);
                s0 = __builtin_amdgcn_mfma_f32_32x32x16_bf16(a0, qf[st], s0, 0, 0, 0);
                s1 = __builtin_amdgcn_mfma_f32_32x32x16_bf16(a1, qf[st], s1, 0, 0, 0);
                if ((st & 3) == 3) __builtin_amdgcn_sched_barrier(0);
            }
            if (!SBK) {
                const bool need_mask = (k0 + 63 > qw0);
                if (need_mask) {
#pragma unroll
                    for (int i = 0; i < 16; ++i) { const int key = k0 + crow(i, hi); if (key > myq) s0[i] = -INFINITY; if (key + 32 > myq) s1[i] = -INFINITY; }
                }
                float mx = s0[0];
#pragma unroll
                for (int i = 1; i < 16; ++i) mx = fmaxf(mx, s0[i]);
#pragma unroll
                for (int i = 0; i < 16; ++i) mx = fmaxf(mx, s1[i]);
                mx = fmaxf(mx, __shfl_xor(mx, 32));
                const float m_new = fmaxf(m_run, mx);
                const float alpha = __builtin_amdgcn_exp2f((m_run - m_new) * c2);
                m_run = m_new;
                const float mc = m_new * c2;
                float ls = 0.f;
#pragma unroll
                for (int i = 0; i < 16; ++i) { s0[i] = __builtin_amdgcn_exp2f(s0[i] * c2 - mc); ls += s0[i]; }
#pragma unroll
                for (int i = 0; i < 16; ++i) { s1[i] = __builtin_amdgcn_exp2f(s1[i] * c2 - mc); ls += s1[i]; }
                l_run = l_run * alpha + ls;
#pragma unroll
                for (int d = 0; d < 4; ++d)
#pragma unroll
                    for (int i = 0; i < 16; ++i) o[d][i] *= alpha;
            } else {
                const bool need_mask = (k0 + 63 >= qw0);
                float lomv[32], own[8], par[8];
#pragma unroll
                for (int sub = 0; sub < 2; ++sub)
#pragma unroll
                    for (int i = 0; i < 16; ++i) {
                        const float z = (sub ? s1[i] : s0[i]) * qk_scale;
                        const float e = __builtin_amdgcn_exp2f(-fabsf(z) * 1.4426950408889634f);
                        float lom = -(fmaxf(z, 0.f) + __builtin_amdgcn_logf(1.0f + e) * 0.6931471805599453f);
                        float lb = z + lom;
                        if (need_mask) { const int key = k0 + 32 * sub + crow(i, hi); if (key >= myq) { lom = 0.f; lb = -INFINITY; } }
                        lomv[16 * sub + i] = lom;
                        if (sub) s1[i] = lb; else s0[i] = lb;
                    }
#pragma unroll
                for (int m = 0; m < 8; ++m) { own[m] = (lomv[4 * m] + lomv[4 * m + 1]) + (lomv[4 * m + 2] + lomv[4 * m + 3]); par[m] = __shfl_xor(own[m], 32); }
                float Tm = 0.f;
#pragma unroll
                for (int m = 7; m >= 0; --m) {
                    float run = Tm + carry + (hi == 0 ? par[m] : 0.f);
#pragma unroll
                    for (int r = 3; r >= 0; --r) {
                        const int idx = 4 * m + r;
                        const float lb = (idx >= 16) ? s1[idx - 16] : s0[idx];
                        const float a = __builtin_amdgcn_exp2f((lb + run) * 1.4426950408889634f);
                        if (idx >= 16) s1[idx - 16] = a; else s0[idx] = a;
                        run += lomv[idx];
                    }
                    Tm += own[m] + par[m];
                }
                carry += Tm;
            }
            unsigned pk[16];
#pragma unroll
            for (int js = 0; js < 2; ++js)
#pragma unroll
                for (int w = 0; w < 4; ++w) { pk[4 * js + w] = cvt_pk(s0[8 * js + 2 * w], s0[8 * js + 2 * w + 1]); pk[8 + 4 * js + w] = cvt_pk(s1[8 * js + 2 * w], s1[8 * js + 2 * w + 1]); }
            const LAS unsigned char* vb = lds + (b ? AT_V1 : AT_V0) + voff;
#pragma unroll
            for (int dt = 0; dt < 4; ++dt) {
                __builtin_amdgcn_sched_barrier(0);
#pragma unroll
                for (int ks = 0; ks < 4; ++ks) {
                    const s16x4 lo = vtr(vb + (16 * ks) * AT_VROW + dt * 64), h4 = vtr(vb + (16 * ks + 8) * AT_VROW + dt * 64);
                    const bf16x8 A = (bf16x8){lo[0], lo[1], lo[2], lo[3], h4[0], h4[1], h4[2], h4[3]};
                    const u32x4 pw = (u32x4){pk[4 * ks], pk[4 * ks + 1], pk[4 * ks + 2], pk[4 * ks + 3]};
                    o[dt] = __builtin_amdgcn_mfma_f32_32x32x16_bf16(A, __builtin_bit_cast(bf16x8, pw), o[dt], 0, 0, 0);
                }
            }
        }
        if (more) AT_STORE(b ^ 1);
        __syncthreads();
    }
#undef AT_LOAD
#undef AT_STORE
    float inv = 1.0f;
    if (!SBK) { const float lt = l_run + __shfl_xor(l_run, 32); inv = 1.0f / lt; }
    bf16* orow = Op + (size_t)myq * ldo + 4 * hi;
#pragma unroll
    for (int dt = 0; dt < 4; ++dt)
#pragma unroll
        for (int gi = 0; gi < 4; ++gi) {
            u32x2 w; w.x = cvt_pk(o[dt][4 * gi] * inv, o[dt][4 * gi + 1] * inv); w.y = cvt_pk(o[dt][4 * gi + 2] * inv, o[dt][4 * gi + 3] * inv);
            *(u32x2*)(orow + 32 * dt + 8 * gi) = w;
        }
}

struct Args {
    const float *x, *c; const int* pos; const float *w_ada, *b_ada, *g1, *g2, *w_in, *g_ql, *g_kvl, *w_uq, *w_ukv, *g_qh, *g_kh, *w_pa, *w_pb, *w_out, *w_fi, *w_fo;
    float* out; unsigned char* ws;
};

__device__ __forceinline__ void transpose_item(const float* __restrict__ W, int K, int N, bf16* __restrict__ WT, int k0, int n0, int dest_row0, const float* __restrict__ kgain, LAS float* scr, int lane) {
#pragma unroll 8
    for (int i = 0; i < 32; ++i) { const int kk = 2 * i + (lane >> 5); float v = W[(size_t)(k0 + kk) * N + n0 + (lane & 31)]; if (kgain) v *= kgain[k0 + kk]; scr[kk * 33 + (lane & 31)] = v; }
    asm volatile("s_waitcnt lgkmcnt(0)" ::: "memory");
    const int c = lane & 7;
#pragma unroll
    for (int j = 0; j < 4; ++j) { const int n = (lane >> 3) + 8 * j; const LAS float* s = scr + (8 * c) * 33 + n;
        u32x4 o; o.x = cvt_pk(s[0 * 33], s[1 * 33]); o.y = cvt_pk(s[2 * 33], s[3 * 33]); o.z = cvt_pk(s[4 * 33], s[5 * 33]); o.w = cvt_pk(s[6 * 33], s[7 * 33]);
        *(u32x4*)(WT + (size_t)(dest_row0 + n) * K + k0 + 8 * c) = o; }
    asm volatile("s_waitcnt lgkmcnt(0)" ::: "memory");
}

__device__ __forceinline__ void p0_prologue(const Args& a, LAS unsigned char* lds, int gw, int NGW, int wave, int lane) {
    unsigned char* ws = a.ws;
    float* part = (float*)(ws + WS_KVRAW);
    for (int it = gw; it < 48 * NPART; it += NGW) {
        const int cgp = it % 48, kc = it / 48;
        float sv[4];
#pragma unroll
        for (int b = 0; b < 4; ++b) { const float cv = a.c[b * DM + kc * 64 + lane]; sv[b] = cv * fast_sigmoid(cv); }
        f32x4 acc[4];
#pragma unroll
        for (int b = 0; b < 4; ++b) acc[b] = (f32x4){0.f, 0.f, 0.f, 0.f};
        const float* wp = a.w_ada + (size_t)(kc * 64) * ADA_N + cgp * 256 + lane * 4;
#pragma unroll 8
        for (int kk = 0; kk < 64; ++kk) {
            const f32x4 w = *(const f32x4*)(wp + (size_t)kk * ADA_N);
#pragma unroll
            for (int b = 0; b < 4; ++b) { const float s = __uint_as_float(__builtin_amdgcn_readlane(__float_as_uint(sv[b]), kk)); acc[b] += w * s; }
        }
#pragma unroll
        for (int b = 0; b < 4; ++b) *(f32x4*)(part + (size_t)(kc * 4 + b) * ADA_N + cgp * 256 + lane * 4) = acc[b];
    }
    LAS float* scr = (LAS float*)(lds + wave * 8704);
    bf16* Win = (bf16*)(ws + WS_WIN); bf16* Wuq = (bf16*)(ws + WS_WUQ); bf16* Wukv = (bf16*)(ws + WS_WUKV); bf16* Wpa = (bf16*)(ws + WS_WPA); bf16* Wpb = (bf16*)(ws + WS_WPB);
    bf16* Wout = (bf16*)(ws + WS_WOUT); bf16* Wfi = (bf16*)(ws + WS_WFI); bf16* Wfo = (bf16*)(ws + WS_WFO);
    constexpr int I_IN = (DM / 64) * (DIN / 32), I_UQ = (512 / 64) * (1536 / 32), I_UKV = (512 / 64) * (2048 / 32), I_P = (1024 / 64) * (DM / 32), I_OUT = (DM / 64) * (DM / 32),
                  I_FI = (DM / 64) * (2 * DFF / 32), I_FO = (DFF / 64) * (DM / 32);
    constexpr int NITEMS = I_IN + I_UQ + I_UKV + 2 * I_P + I_OUT + I_FI + I_FO;
    for (int it = gw; it < NITEMS; it += NGW) {
        int r = it;
        if (r < I_FI) { const int nblk = 2 * DFF / 32, kb = r / nblk, nb = r % nblk; const int n0 = 32 * nb; const int jn = n0 < DFF ? n0 : n0 - DFF;
            const int dest = 256 * (jn / 128) + (jn % 128) + (n0 < DFF ? 0 : 128);
            transpose_item(a.w_fi, DM, 2 * DFF, Wfi, 64 * kb, n0, dest, nullptr, scr, lane); continue; } r -= I_FI;
        if (r < I_IN) { const int nblk = DIN / 32, kb = r / nblk, nb = r % nblk; const int n0 = 32 * nb; const int dest = n0 < 1088 ? n0 : n0 + 192;
            transpose_item(a.w_in, DM, DIN, Win, 64 * kb, n0, dest, nullptr, scr, lane); continue; } r -= I_IN;
        if (r < I_FO) { const int nblk = DM / 32, kb = r / nblk, nb = r % nblk; transpose_item(a.w_fo, DFF, DM, Wfo, 64 * kb, 32 * nb, 32 * nb, nullptr, scr, lane); continue; } r -= I_FO;
        if (r < I_OUT) { const int nblk = DM / 32, kb = r / nblk, nb = r % nblk; transpose_item(a.w_out, DM, DM, Wout, 64 * kb, 32 * nb, 32 * nb, nullptr, scr, lane); continue; } r -= I_OUT;
        if (r < I_P) { const int nblk = DM / 32, kb = r / nblk, nb = r % nblk; transpose_item(a.w_pa, 1024, DM, Wpa, 64 * kb, 32 * nb, 32 * nb, nullptr, scr, lane); continue; } r -= I_P;
        if (r < I_P) { const int nblk = DM / 32, kb = r / nblk, nb = r % nblk; transpose_item(a.w_pb, 1024, DM, Wpb, 64 * kb, 32 * nb, 32 * nb, nullptr, scr, lane); continue; } r -= I_P;
        if (r < I_UQ) { const int nblk = 1536 / 32, kb = r / nblk, nb = r % nblk; transpose_item(a.w_uq, 512, 1536, Wuq, 64 * kb, 32 * nb, 32 * nb, a.g_ql, scr, lane); continue; } r -= I_UQ;
        { const int nblk = 2048 / 32, kb = r / nblk, nb = r % nblk; transpose_item(a.w_ukv, 512, 2048, Wukv, 64 * kb, 32 * nb, 32 * nb, a.g_kvl, scr, lane); }
    }
    for (int p = gw * 64 + lane; p < 192 * DM / 8; p += NGW * 64) *(u32x4*)(Win + (size_t)1088 * DM + (size_t)p * 8) = (u32x4){0u, 0u, 0u, 0u};
}

__device__ __forceinline__ void norm_rows(const float* __restrict__ src, bf16* __restrict__ dst, const LAS float* scale, const LAS float* shift, int row0, int wave, int lane) {
#pragma unroll 1
    for (int r = 0; r < 8; ++r) {
        const int row = row0 + wave * 8 + r;
        const f32x4* xr = (const f32x4*)(src + (size_t)row * DM) + lane;
        f32x4 v[8]; float ss = 0.f;
#pragma unroll
        for (int j = 0; j < 8; ++j) { v[j] = xr[64 * j]; ss += (v[j].x * v[j].x + v[j].y * v[j].y) + (v[j].z * v[j].z + v[j].w * v[j].w); }
        const float rstd = 1.0f / sqrtf(wave_sum(ss) * (1.0f / DM) + EPS);
        u32x2* orow = (u32x2*)(dst + (size_t)row * DM) + lane;
#pragma unroll
        for (int j = 0; j < 8; ++j) { const int col = 4 * (64 * j + lane); const f32x4 sc = *(const LAS f32x4*)(scale + col), sh = *(const LAS f32x4*)(shift + col);
            const f32x4 y = v[j] * rstd * sc + sh; u32x2 w; w.x = cvt_pk(y.x, y.y); w.y = cvt_pk(y.z, y.w); orow[64 * j] = w; }
    }
}

__global__ void __launch_bounds__(512, 2) fwd_megakernel(Args a) {
    extern __shared__ __attribute__((aligned(16))) unsigned char lds_raw[];
    LAS unsigned char* lds = (LAS unsigned char*)lds_raw;
    cg::grid_group grid = cg::this_grid();
    const int tid = threadIdx.x, lane = tid & 63, wave = __builtin_amdgcn_readfirstlane(tid >> 6);
    const int G = gridDim.x, bx = blockIdx.x;
    const int vcu = (G % 8 == 0) ? (bx % 8) * (G / 8) + bx / 8 : bx;
    const int gw = vcu * 8 + wave, NGW = G * 8;
    unsigned char* ws = a.ws;
    float* ada = (float*)(ws + WS_ADA);
    float* part = (float*)(ws + WS_KVRAW);
    bf16* Win = (bf16*)(ws + WS_WIN); bf16* Wuq = (bf16*)(ws + WS_WUQ); bf16* Wukv = (bf16*)(ws + WS_WUKV); bf16* Wpa = (bf16*)(ws + WS_WPA); bf16* Wpb = (bf16*)(ws + WS_WPB);
    bf16* Wout = (bf16*)(ws + WS_WOUT); bf16* Wfi = (bf16*)(ws + WS_WFI); bf16* Wfo = (bf16*)(ws + WS_WFO);
    bf16* proj = (bf16*)(ws + WS_PROJ); bf16* act = (bf16*)(ws + WS_PROJ);
    bf16* kvraw = (bf16*)(ws + WS_KVRAW); bf16* merged = (bf16*)(ws + WS_KVRAW);
    bf16* ybuf = (bf16*)(ws + WS_Y); bf16* h2 = (bf16*)(ws + WS_Y);
    bf16* hbuf = (bf16*)a.out; bf16* qbuf = (bf16*)a.out; bf16* kbuf = (bf16*)((unsigned char*)a.out + DO_K);
    LAS float* tscale = (LAS float*)lds; LAS float* tshift = (LAS float*)(lds + 8192);

    p0_prologue(a, lds, gw, NGW, wave, lane);
    grid.sync();

    for (int e = bx * 512 + tid; e < NB * ADA_N; e += G * 512) { const int b = e / ADA_N, n = e % ADA_N; float v = a.b_ada[n];
        for (int p = 0; p < NPART; ++p) v += part[(size_t)(p * 4 + b) * ADA_N + n];
        ada[e] = v; }
    for (int ch = bx; ch < T / 64; ch += G) {
        const int b = (ch * 64) / SEQ;
        __syncthreads();
        for (int d = tid; d < DM; d += 512) { float sh = a.b_ada[d], sc = a.b_ada[DM + d];
            for (int p = 0; p < NPART; ++p) { sh += part[(size_t)(p * 4 + b) * ADA_N + d]; sc += part[(size_t)(p * 4 + b) * ADA_N + DM + d]; }
            tscale[d] = a.g1[d] * (1.0f + sc); tshift[d] = sh; }
        __syncthreads();
        norm_rows(a.x, hbuf, tscale, tshift, ch * 64, wave, lane);
    }
    grid.sync();

    { pg8::Gemm g{hbuf, Win, T, PLD, DM, DM, DM}; pg8::StaticOrder S; S.init(T, PLD, G, bx); pg8::EpiBf16 E{proj, PLD}; pg8::gemm_phase(lds, g, S, E); }
    grid.sync();

    { pg8::Gemm g{proj, Wuq, T, 1536, 512, PLD, 512}; pg8::StaticOrder S; S.init(T, 1536, G, bx); pg8::EpiBf16 E{qbuf, 1536}; pg8::gemm_phase(lds, g, S, E); }
    { pg8::Gemm g{proj + 512, Wukv, T, 2048, 512, PLD, 512}; pg8::StaticOrder S; S.init(T, 2048, G, bx); pg8::EpiBf16 E{kvraw, 2048}; pg8::gemm_phase(lds, g, S, E); }
    grid.sync();

    for (int t = gw; t < T; t += NGW) {
        const bf16* prow = proj + (size_t)t * PLD;
        float aq, akv;
        { const u32x4 u = *(const u32x4*)(prow + lane * 8); float s = bf_lo(u.x) * bf_lo(u.x) + bf_hi(u.x) * bf_hi(u.x) + bf_lo(u.y) * bf_lo(u.y) + bf_hi(u.y) * bf_hi(u.y)
              + bf_lo(u.z) * bf_lo(u.z) + bf_hi(u.z) * bf_hi(u.z) + bf_lo(u.w) * bf_lo(u.w) + bf_hi(u.w) * bf_hi(u.w);
          aq = 1.0f / sqrtf(wave_sum(s) * (1.0f / 512.0f) + EPS); }
        { const u32x4 u = *(const u32x4*)(prow + 512 + lane * 8); float s = bf_lo(u.x) * bf_lo(u.x) + bf_hi(u.x) * bf_hi(u.x) + bf_lo(u.y) * bf_lo(u.y) + bf_hi(u.y) * bf_hi(u.y)
              + bf_lo(u.z) * bf_lo(u.z) + bf_hi(u.z) * bf_hi(u.z) + bf_lo(u.w) * bf_lo(u.w) + bf_hi(u.w) * bf_hi(u.w);
          akv = 1.0f / sqrtf(wave_sum(s) * (1.0f / 512.0f) + EPS); }
        const float kpe = bf2f(prow[C_KPE + lane]);
        const float ang = (float)a.pos[t] * ROPE_FREQ[lane & 31];
        double rev = (double)ang * 0.15915494309189535; rev -= __builtin_rint(rev);
        const float sn = __builtin_amdgcn_sinf((float)rev), cs = __builtin_amdgcn_cosf((float)rev);
        const float gq0 = a.g_qh[lane], gq1 = a.g_qh[64 + lane], gq2 = a.g_qh[128 + lane];
        const float gk0 = a.g_kh[lane], gk1 = a.g_kh[64 + lane], gk2 = a.g_kh[128 + lane];
        bf16* qrow = qbuf + (size_t)t * 1536; bf16* krow = kbuf + (size_t)t * 1536; bf16* kvrow = kvraw + (size_t)t * 2048;
#pragma unroll 2
        for (int h = 0; h < NH; ++h) {
            { bf16* qh = qrow + h * DQK;
              const float e0 = bf2f(qh[lane]) * aq, e1 = bf2f(qh[64 + lane]) * aq, e2 = bf2f(qh[128 + lane]) * aq;
              const float rstd = 1.0f / sqrtf(wave_sum(e0 * e0 + e1 * e1 + e2 * e2) * (1.0f / DQK) + EPS);
              const float f2 = e2 * rstd * gq2, pf = __shfl_xor(f2, 32);
              const float rot = lane < 32 ? f2 * cs - pf * sn : pf * sn + f2 * cs;
              qh[lane] = f2bf(e0 * rstd * gq0); qh[64 + lane] = f2bf(e1 * rstd * gq1); qh[128 + lane] = f2bf(rot); }
            { const bf16* kn = kvrow + h * 256; bf16* kh = krow + h * DQK;
              const float e0 = bf2f(kn[lane]) * akv, e1 = bf2f(kn[64 + lane]) * akv, e2 = kpe;
              const float rstd = 1.0f / sqrtf(wave_sum(e0 * e0 + e1 * e1 + e2 * e2) * (1.0f / DQK) + EPS);
              const float f2 = e2 * rstd * gk2, pf = __shfl_xor(f2, 32);
              const float rot = lane < 32 ? f2 * cs - pf * sn : pf * sn + f2 * cs;
              kh[lane] = f2bf(e0 * rstd * gk0); kh[64 + lane] = f2bf(e1 * rstd * gk1); kh[128 + lane] = f2bf(rot); }
            { unsigned* vp = (unsigned*)(kvrow + h * 256 + 128) + lane; const unsigned u = *vp; *vp = cvt_pk(bf_lo(u) * akv, bf_hi(u) * akv); }
        }
    }
    grid.sync();

    for (int su = vcu; su < 256; su += G) {
        const int bh = su >> 3, p = su & 7, b = bh >> 3, h = bh & 7;
        const size_t r0 = (size_t)b * SEQ;
#pragma unroll 1
        for (int half = 0; half < 2; ++half) {
            const int qb = half ? 15 - p : p;
            attn_unit<false>(lds, qbuf + r0 * 1536 + h * DQK, 1536, kbuf + r0 * 1536 + h * DQK, 1536, kvraw + r0 * 2048 + h * 256 + 128, 2048, ybuf + r0 * DM + h * 128, DM, qb * 256, tid, wave, lane);
            attn_unit<true>(lds, proj + r0 * PLD + C_SBQ + h * 128, PLD, proj + r0 * PLD + C_SBK + h * 128, PLD, proj + r0 * PLD + C_SBV + h * 128, PLD, ybuf + r0 * DM + 1024 + h * 128, DM, qb * 256, tid, wave, lane);
        }
    }
    grid.sync();

    { pg8::Gemm g{ybuf, Wpa, T, DM, 1024, DM, 1024}; pg8::StaticOrder S; S.init(T, DM, G, bx); pg8::EpiGate<false> E{merged, DM, proj + C_GA, PLD}; pg8::gemm_phase(lds, g, S, E); }
    { pg8::Gemm g{ybuf + 1024, Wpb, T, DM, 1024, DM, 1024}; pg8::StaticOrder S; S.init(T, DM, G, bx); pg8::EpiGate<true> E{merged, DM, proj + C_GB, PLD}; pg8::gemm_phase(lds, g, S, E); }
    grid.sync();

    { pg8::Gemm g{merged, Wout, T, DM, DM, DM, DM}; pg8::StaticOrder S; S.init(T, DM, G, bx); pg8::EpiRes E{a.x, a.out, ada + 2 * DM, ADA_N}; pg8::gemm_phase(lds, g, S, E); }
    grid.sync();

    for (int ch = bx; ch < T / 64; ch += G) {
        const int b = (ch * 64) / SEQ;
        __syncthreads();
        for (int d = tid; d < DM; d += 512) { tscale[d] = a.g2[d] * (1.0f + ada[b * ADA_N + 4 * DM + d]); tshift[d] = ada[b * ADA_N + 3 * DM + d]; }
        __syncthreads();
        norm_rows(a.out, h2, tscale, tshift, ch * 64, wave, lane);
    }
    grid.sync();

    { pg8::Gemm g{h2, Wfi, T, 2 * DFF, DM, DM, DM}; pg8::StaticOrder S; S.init(T, 2 * DFF, G, bx); pg8::EpiSwiglu E{act, DFF}; pg8::gemm_phase(lds, g, S, E); }
    grid.sync();

    { pg8::Gemm g{act, Wfo, T, DM, DFF, DFF, DFF}; pg8::StaticOrder S; S.init(T, DM, G, bx); pg8::EpiRes E{a.out, a.out, ada + 5 * DM, ADA_N}; pg8::gemm_phase(lds, g, S, E); }
}

constexpr int LDS_BYTES = 147456;
extern "C" void kernel_launch(void* const* d_in, const int* in_sizes, int n_in, void* d_out, int out_size, void* d_ws, size_t ws_size, hipStream_t stream) {
    static int grid = 0;
    if (grid == 0) {
        if (n_in != 19 || out_size != T * DM || ws_size < WS_END) { fprintf(stderr, "kernel_launch: unexpected problem (n_in %d out %d ws %zu)\n", n_in, out_size, ws_size); grid = -1; return; }
        int dev = 0, cus = 0, per_cu = 0;
        hipGetDevice(&dev); hipDeviceGetAttribute(&cus, hipDeviceAttributeMultiprocessorCount, dev);
        if (hipFuncSetAttribute((const void*)fwd_megakernel, hipFuncAttributeMaxDynamicSharedMemorySize, LDS_BYTES) != hipSuccess) { fprintf(stderr, "kernel_launch: hipFuncSetAttribute failed\n"); grid = -1; return; }
        if (hipOccupancyMaxActiveBlocksPerMultiprocessor(&per_cu, (const void*)fwd_megakernel, 512, LDS_BYTES) != hipSuccess || per_cu < 1) { fprintf(stderr, "kernel_launch: occupancy query failed (%d)\n", per_cu); per_cu = 1; }
        (void)hipGetLastError();
        grid = cus * (per_cu > 1 ? 1 : per_cu);
    }
    if (grid < 0) return;
    Args a{};
    a.x = (const float*)d_in[0]; a.c = (const float*)d_in[1]; a.pos = (const int*)d_in[2]; a.w_ada = (const float*)d_in[3]; a.b_ada = (const float*)d_in[4];
    a.g1 = (const float*)d_in[5]; a.g2 = (const float*)d_in[6]; a.w_in = (const float*)d_in[7]; a.g_ql = (const float*)d_in[8]; a.g_kvl = (const float*)d_in[9];
    a.w_uq = (const float*)d_in[10]; a.w_ukv = (const float*)d_in[11]; a.g_qh = (const float*)d_in[12]; a.g_kh = (const float*)d_in[13]; a.w_pa = (const float*)d_in[14];
    a.w_pb = (const float*)d_in[15]; a.w_out = (const float*)d_in[16]; a.w_fi = (const float*)d_in[17]; a.w_fo = (const float*)d_in[18];
    a.out = (float*)d_out; a.ws = (unsigned char*)d_ws;
    void* args[] = {&a};
    hipError_t e = hipLaunchCooperativeKernel((const void*)fwd_megakernel, dim3(grid), dim3(512), args, LDS_BYTES, stream);
    if (e != hipSuccess) fprintf(stderr, "kernel_launch: cooperative launch failed: %s (grid %d)\n", hipGetErrorString(e), grid);
}
```

```cpp
#include <hip/hip_runtime.h>
#include <hip/hip_cooperative_groups.h>
#include <cstdio>
#include <cstdint>
namespace cg = cooperative_groups;

#define LAS __attribute__((address_space(3)))
typedef unsigned short bf16;
typedef short bf16x8 __attribute__((ext_vector_type(8)));
typedef short s16x4 __attribute__((ext_vector_type(4)));
typedef float f32x2 __attribute__((ext_vector_type(2)));
typedef float f32x4 __attribute__((ext_vector_type(4)));
typedef float f32x16 __attribute__((ext_vector_type(16)));
typedef unsigned u32x4 __attribute__((ext_vector_type(4)));
typedef unsigned u32x2 __attribute__((ext_vector_type(2)));
typedef __bf16 bf16x2_t __attribute__((ext_vector_type(2)));

constexpr int NB = 4, SEQ = 4096, T = NB * SEQ, DM = 2048;
constexpr int NH = 8, DQK = 192, DFF = 5632, DIN = 8256, PLD = 8448;
constexpr int C_KPE = 1024, C_SBQ = 1280, C_SBK = 2304, C_SBV = 3328, C_GA = 4352, C_GB = 6400;
constexpr int ADA_N = 6 * DM;
constexpr int NPART = 32;
constexpr float EPS = 1e-6f;
constexpr size_t MiB = 1u << 20;
constexpr size_t WS_ADA = 0;
constexpr size_t WS_WIN = 1 * MiB, WS_WUQ = 34 * MiB, WS_WUKV = 36 * MiB, WS_WPA = 38 * MiB, WS_WPB = 42 * MiB, WS_WOUT = 46 * MiB, WS_WFI = 54 * MiB, WS_WFO = 98 * MiB;
constexpr size_t WS_PROJ = 120 * MiB;
constexpr size_t WS_KVRAW = 384 * MiB;
constexpr size_t WS_Y = 448 * MiB;
constexpr size_t WS_END = 512 * MiB;
constexpr size_t DO_K = 48 * MiB;

__device__ const float ROPE_FREQ[32] = {1.0f, 0.7498942613601685f, 0.5623413324356079f, 0.4216965138912201f, 0.3162277638912201f, 0.23713737726211548f, 0.17782793939113617f, 0.133352130651474f,
    0.10000000149011612f, 0.07498941570520401f, 0.05623413249850273f, 0.04216965287923813f, 0.03162277489900589f, 0.023713737726211548f, 0.017782794311642647f, 0.01333521492779255f,
    0.009999999776482582f, 0.007498941849917173f, 0.005623413249850273f, 0.0042169648222625256f, 0.003162277629598975f, 0.00237137358635664f, 0.0017782794311642647f, 0.0013335214462131262f,
    0.0010000000474974513f, 0.0007498942431993783f, 0.000562341301701963f, 0.0004216965171508491f, 0.0003162277571391314f, 0.00023713737027719617f, 0.00017782794020604342f, 0.0001333521504420787f};

__device__ __forceinline__ unsigned cvt_pk(float lo, float hi) { f32x2 v = {lo, hi}; bf16x2_t b = __builtin_convertvector(v, bf16x2_t); return __builtin_bit_cast(unsigned, b); }
__device__ __forceinline__ float bf_lo(unsigned u) { return __uint_as_float(u << 16); }
__device__ __forceinline__ float bf_hi(unsigned u) { return __uint_as_float(u & 0xffff0000u); }
__device__ __forceinline__ float bf2f(bf16 b) { return __uint_as_float((unsigned)b << 16); }
__device__ __forceinline__ bf16 f2bf(float f) { return (bf16)(cvt_pk(f, 0.f) & 0xffffu); }
__device__ __forceinline__ float wave_sum(float v) {
#pragma unroll
    for (int o = 1; o < 64; o <<= 1) v += __shfl_xor(v, o);
    return v;
}
__device__ __forceinline__ float fast_sigmoid(float x) { return __builtin_amdgcn_rcpf(1.0f + __expf(-x)); }

namespace pg8 {
constexpr int BM = 256, BK = 64, HALF = 128, HTB = HALF * BK * 2, STAGE_BYTES = 8 * HTB, NXCD = 8, WGM = 8;
__host__ __device__ __forceinline__ int lds_byte(int r, int c) { const int st = (r >> 4) * 2 + (c >> 5), rr = r & 15, cc = c & 31, ob = rr * 64 + cc * 2; return st * 1024 + (ob ^ (((ob >> 9) & 1) << 5)); }
__host__ __device__ __forceinline__ void stage_rc(int b, int& R, int& C) { const int st = b / 1024, sb = b % 1024, swz = sb ^ (((sb >> 9) & 1) << 5); R = (st >> 1) * 16 + swz / 64; C = (st & 1) * 32 + (swz % 64) / 2; }
__host__ __device__ __forceinline__ int perm32(int rho) { const int n = rho >> 4, i = rho & 15; return 8 * (i >> 2) + 4 * n + (i & 3); }
struct Unit { int pm, pn; };
struct Gemm { const bf16* A; const bf16* Bt; int M, N, K, lda, ldb; };
struct StaticOrder {
    int nM, nN, nwg, G, c;
    __device__ void init(int M, int N, int G_, int c_) { nM = M / BM; nN = N / BM; nwg = nM * nN; G = G_; c = c_; }
    __device__ bool next(int i, Unit& u) const {
        const long L = (long)i * G + c; if (L >= nwg) return false;
        int wgid = (int)L; { const int q = nwg / NXCD, r = nwg % NXCD, xcd = wgid % NXCD, off = wgid / NXCD; wgid = (xcd < r ? xcd * (q + 1) : r * (q + 1) + (xcd - r) * q) + off; }
        const int nig = WGM * nN, gid = wgid / nig, fm = gid * WGM, gsz = (nM - fm) < WGM ? (nM - fm) : WGM;
        u.pm = fm + ((wgid % nig) % gsz); u.pn = (wgid % nig) / gsz; return true;
    }
};
typedef f32x4 Acc[2][2][4][2];

struct EpiBf16 {
    bf16* O; int ldc;
    __device__ __forceinline__ void operator()(const Acc& acc, const Unit& u, int wr, int wc, int fr, int fq) const {
        const int row0 = u.pm * BM + wr * 64 + fr, col0 = u.pn * BM + wc * 32 + 8 * fq;
#pragma unroll
        for (int ai = 0; ai < 2; ++ai)
#pragma unroll
            for (int m = 0; m < 4; ++m) { bf16* rowp = O + (size_t)(row0 + ai * HALF + m * 16) * ldc + col0;
#pragma unroll
                for (int bj = 0; bj < 2; ++bj) { const f32x4 v0 = acc[ai][bj][m][0], v1 = acc[ai][bj][m][1];
                    u32x4 w; w.x = cvt_pk(v0[0], v0[1]); w.y = cvt_pk(v0[2], v0[3]); w.z = cvt_pk(v1[0], v1[1]); w.w = cvt_pk(v1[2], v1[3]);
                    *(u32x4*)(rowp + bj * HALF) = w; } }
    }
};
template <bool ACCUM> struct EpiGate {
    bf16* O; int ldc; const bf16* gate; int ldg;
    __device__ __forceinline__ void operator()(const Acc& acc, const Unit& u, int wr, int wc, int fr, int fq) const {
        const int row0 = u.pm * BM + wr * 64 + fr, col0 = u.pn * BM + wc * 32 + 8 * fq;
#pragma unroll
        for (int ai = 0; ai < 2; ++ai)
#pragma unroll
            for (int m = 0; m < 4; ++m) { const size_t row = (size_t)(row0 + ai * HALF + m * 16);
#pragma unroll
                for (int bj = 0; bj < 2; ++bj) {
                    const u32x4 g = *(const u32x4*)(gate + row * ldg + col0 + bj * HALF);
                    const f32x4 v0 = acc[ai][bj][m][0], v1 = acc[ai][bj][m][1];
                    float r[8];
                    r[0] = v0[0] * fast_sigmoid(bf_lo(g.x)); r[1] = v0[1] * fast_sigmoid(bf_hi(g.x)); r[2] = v0[2] * fast_sigmoid(bf_lo(g.y)); r[3] = v0[3] * fast_sigmoid(bf_hi(g.y));
                    r[4] = v1[0] * fast_sigmoid(bf_lo(g.z)); r[5] = v1[1] * fast_sigmoid(bf_hi(g.z)); r[6] = v1[2] * fast_sigmoid(bf_lo(g.w)); r[7] = v1[3] * fast_sigmoid(bf_hi(g.w));
                    bf16* op = O + row * ldc + col0 + bj * HALF;
                    if (ACCUM) { const u32x4 o = *(const u32x4*)op;
                        r[0] += bf_lo(o.x); r[1] += bf_hi(o.x); r[2] += bf_lo(o.y); r[3] += bf_hi(o.y); r[4] += bf_lo(o.z); r[5] += bf_hi(o.z); r[6] += bf_lo(o.w); r[7] += bf_hi(o.w); }
                    u32x4 w; w.x = cvt_pk(r[0], r[1]); w.y = cvt_pk(r[2], r[3]); w.z = cvt_pk(r[4], r[5]); w.w = cvt_pk(r[6], r[7]);
                    *(u32x4*)op = w; } }
    }
};
struct EpiRes {
    const float* base; float* out; const float* gt; int gt_ld;
    __device__ __forceinline__ void operator()(const Acc& acc, const Unit& u, int wr, int wc, int fr, int fq) const {
        const int row0 = u.pm * BM + wr * 64 + fr, col0 = u.pn * BM + wc * 32 + 8 * fq;
        const float* gp = gt + (size_t)((u.pm * BM) / SEQ) * gt_ld + col0;
        f32x4 gv[2][2];
#pragma unroll
        for (int bj = 0; bj < 2; ++bj)
#pragma unroll
            for (int n = 0; n < 2; ++n) gv[bj][n] = *(const f32x4*)(gp + bj * HALF + 4 * n);
#pragma unroll
        for (int ai = 0; ai < 2; ++ai)
#pragma unroll
            for (int m = 0; m < 4; ++m) { const size_t off = (size_t)(row0 + ai * HALF + m * 16) * DM + col0;
#pragma unroll
                for (int bj = 0; bj < 2; ++bj)
#pragma unroll
                    for (int n = 0; n < 2; ++n) { const f32x4 b = *(const f32x4*)(base + off + bj * HALF + 4 * n);
                        *(f32x4*)(out + off + bj * HALF + 4 * n) = b + gv[bj][n] * acc[ai][bj][m][n]; } }
    }
};
struct EpiSwiglu {
    bf16* O; int ldc;
    __device__ __forceinline__ void operator()(const Acc& acc, const Unit& u, int wr, int wc, int fr, int fq) const {
        const int row0 = u.pm * BM + wr * 64 + fr, col0 = u.pn * HALF + wc * 32 + 8 * fq;
#pragma unroll
        for (int ai = 0; ai < 2; ++ai)
#pragma unroll
            for (int m = 0; m < 4; ++m) { float r[8];
#pragma unroll
                for (int n = 0; n < 2; ++n)
#pragma unroll
                    for (int e = 0; e < 4; ++e) { const float g = acc[ai][0][m][n][e], up = acc[ai][1][m][n][e]; r[4 * n + e] = g * fast_sigmoid(g) * up; }
                u32x4 w; w.x = cvt_pk(r[0], r[1]); w.y = cvt_pk(r[2], r[3]); w.z = cvt_pk(r[4], r[5]); w.w = cvt_pk(r[6], r[7]);
                *(u32x4*)(O + (size_t)(row0 + ai * HALF + m * 16) * ldc + col0) = w; }
    }
};

template <class Epi>
__device__ __forceinline__ void gemm_phase(LAS unsigned char* lds, const Gemm g, const StaticOrder& S, const Epi& E) {
    int tid = threadIdx.x;
    asm volatile("" : "+v"(tid));
    const int wid = __builtin_amdgcn_readfirstlane(tid >> 6), lane = tid & 63, wr = wid >> 2, wc = wid & 3, fr = lane & 15, fq = lane >> 4;
    const int K = g.K, nt = K / BK;
    unsigned voffA[2], voffB[2];
#pragma unroll
    for (int i = 0; i < 2; ++i) { int R, C; stage_rc(tid * 16 + i * 8192, R, C); const int Rb = (R & ~31) + perm32(R & 31);
        voffA[i] = (unsigned)(R * g.lda + C) * 2u; voffB[i] = (unsigned)(Rb * g.ldb + C) * 2u; }
    const size_t kstep = (size_t)(BK * 2);
    const size_t hstepA = (size_t)HALF * g.lda * 2, hstepB = (size_t)HALF * g.ldb * 2;
    const size_t tstepA = 2 * hstepA, tstepB = 2 * hstepB;
    const unsigned ldsw = (unsigned)wid * 1024u;
    const int aoff = lds_byte(wr * 64 + fr, fq * 8), boff = lds_byte(wc * 32 + fr, fq * 8);
#define PG8_SA(b, h) (((b) * 2 + (h)) * HTB)
#define PG8_SB(b, h) ((4 + (b) * 2 + (h)) * HTB)
#define PG8_STAGE(bufoff, gbase, voff) do { _Pragma("unroll") for (int _i = 0; _i < 2; ++_i) \
        __builtin_amdgcn_global_load_lds((const unsigned*)((const char*)(gbase) + (voff)[_i]), (LAS unsigned*)(lds + (bufoff) + ldsw + _i * 8192), 16, 0, 0); } while (0)
#define PG8_LDA(dst, b, h) do { _Pragma("unroll") for (int m = 0; m < 4; ++m) _Pragma("unroll") for (int k = 0; k < 2; ++k) dst[m][k] = *(const LAS bf16x8*)(lds + PG8_SA(b, h) + aoff + m * 2048 + k * 1024); } while (0)
#define PG8_LDB(dst, b, h) do { _Pragma("unroll") for (int n = 0; n < 2; ++n) _Pragma("unroll") for (int k = 0; k < 2; ++k) dst[n][k] = *(const LAS bf16x8*)(lds + PG8_SB(b, h) + boff + n * 2048 + k * 1024); } while (0)
#define PG8_MMA(ai, bj, At, Bt) do { __builtin_amdgcn_s_setprio(1); _Pragma("unroll") for (int m = 0; m < 4; ++m) _Pragma("unroll") for (int n = 0; n < 2; ++n) _Pragma("unroll") for (int k = 0; k < 2; ++k) \
        acc[ai][bj][m][n] = __builtin_amdgcn_mfma_f32_16x16x32_bf16(Bt[n][k], At[m][k], acc[ai][bj][m][n], 0, 0, 0); __builtin_amdgcn_s_setprio(0); } while (0)
#define PG8_WAIT_V(n) asm volatile("s_waitcnt vmcnt(" #n ")" ::: "memory")
#define PG8_WAIT_L(n) asm volatile("s_waitcnt lgkmcnt(" #n ")" ::: "memory")
#define PG8_BAR __builtin_amdgcn_s_barrier()
#define PG8_SCHED __builtin_amdgcn_sched_barrier(0)
    Unit cur, nxt; int ui = 0;
    if (!S.next(0, cur)) return;
    Acc acc;
#pragma unroll
    for (int a = 0; a < 2; ++a)
#pragma unroll
        for (int b = 0; b < 2; ++b)
#pragma unroll
            for (int m = 0; m < 4; ++m)
#pragma unroll
                for (int n = 0; n < 2; ++n) acc[a][b][m][n] = (f32x4){0.f, 0.f, 0.f, 0.f};
    bf16x8 At[4][2], B0[2][2], B1[2][2];
    const char* cA = (const char*)g.A + (size_t)cur.pm * tstepA; const char* cB = (const char*)g.Bt + (size_t)cur.pn * tstepB;
    PG8_STAGE(PG8_SB(0, 0), cB, voffB); PG8_STAGE(PG8_SB(0, 1), cB + hstepB, voffB); PG8_STAGE(PG8_SA(0, 0), cA, voffA); PG8_STAGE(PG8_SA(0, 1), cA + hstepA, voffA);
    if (wr == 1) PG8_BAR;
    PG8_WAIT_V(2); PG8_BAR;
    PG8_STAGE(PG8_SB(1, 0), cB + kstep, voffB); PG8_STAGE(PG8_SA(1, 0), cA + kstep, voffA); PG8_STAGE(PG8_SB(1, 1), cB + hstepB + kstep, voffB);
    PG8_WAIT_V(6); PG8_BAR;
    for (;;) {
        const bool has_next = S.next(ui + 1, nxt);
        const char* nA = has_next ? (const char*)g.A + (size_t)nxt.pm * tstepA : cA; const char* nB = has_next ? (const char*)g.Bt + (size_t)nxt.pn * tstepB : cB;
        for (int t = 0; t < nt; t += 2) {
            const bool last = (t == nt - 2);
            const char* a1 = cA + (size_t)(t + 1) * kstep;
            const char* a2 = last ? nA : cA + (size_t)(t + 2) * kstep; const char* b2 = last ? nB : cB + (size_t)(t + 2) * kstep;
            const char* a3 = a2 + kstep; const char* b3 = b2 + kstep;
            PG8_LDB(B0, 0, 0); PG8_LDB(B1, 0, 1); PG8_SCHED; PG8_LDA(At, 0, 0); PG8_STAGE(PG8_SA(1, 1), a1 + hstepA, voffA);
            PG8_WAIT_V(8); PG8_WAIT_L(0); PG8_BAR; PG8_MMA(0, 0, At, B0); PG8_MMA(0, 1, At, B1); PG8_BAR; PG8_SCHED;
            PG8_LDA(At, 0, 1); PG8_STAGE(PG8_SB(0, 0), b2, voffB); PG8_STAGE(PG8_SB(0, 1), b2 + hstepB, voffB); PG8_STAGE(PG8_SA(0, 0), a2, voffA);
            PG8_WAIT_V(8); PG8_WAIT_L(0); PG8_BAR; PG8_MMA(1, 0, At, B0); PG8_MMA(1, 1, At, B1); PG8_BAR; PG8_SCHED;
            PG8_LDB(B0, 1, 0); PG8_LDB(B1, 1, 1); PG8_SCHED; PG8_LDA(At, 1, 0); PG8_STAGE(PG8_SA(0, 1), a2 + hstepA, voffA);
            PG8_WAIT_V(8); PG8_WAIT_L(0); PG8_BAR; PG8_MMA(0, 0, At, B0); PG8_MMA(0, 1, At, B1); PG8_BAR; PG8_SCHED;
            PG8_LDA(At, 1, 1); PG8_STAGE(PG8_SB(1, 0), b3, voffB); PG8_STAGE(PG8_SB(1, 1), b3 + hstepB, voffB); PG8_STAGE(PG8_SA(1, 0), a3, voffA);
            PG8_WAIT_V(8); PG8_WAIT_L(0); PG8_BAR; PG8_MMA(1, 0, At, B0); PG8_MMA(1, 1, At, B1); PG8_BAR; PG8_SCHED;
        }
        if (wr == 0) PG8_BAR;
        E(acc, cur, wr, wc, fr, fq);
        if (!has_next) break;
#pragma unroll
        for (int a = 0; a < 2; ++a)
#pragma unroll
            for (int b = 0; b < 2; ++b)
#pragma unroll
                for (int m = 0; m < 4; ++m)
#pragma unroll
                    for (int n = 0; n < 2; ++n) acc[a][b][m][n] = (f32x4){0.f, 0.f, 0.f, 0.f};
        cur = nxt; cA = nA; cB = nB; ++ui;
        if (wr == 1) PG8_BAR;
    }
    PG8_WAIT_V(0);
    PG8_BAR;
#undef PG8_SA
#undef PG8_SB
#undef PG8_STAGE
#undef PG8_LDA
#undef PG8_LDB
#undef PG8_MMA
#undef PG8_WAIT_V
#undef PG8_WAIT_L
#undef PG8_BAR
#undef PG8_SCHED
}
}

__device__ __forceinline__ int crow(int r, int hi) { return (r & 3) + 8 * (r >> 2) + 4 * hi; }
__device__ __forceinline__ s16x4 vtr(const LAS unsigned char* p) { typedef short v4i16_t __attribute__((ext_vector_type(4)));
    return __builtin_bit_cast(s16x4, __builtin_amdgcn_ds_read_tr16_b64_v4i16((LAS v4i16_t*)p)); }
constexpr int AT_K0 = 0, AT_K1 = 25600, AT_V0 = 51200, AT_V1 = 71680, AT_VROW = 320, AT_CNT = 92160;

template <bool SBK>
__device__ __forceinline__ void attn_unit(LAS unsigned char* lds, const bf16* __restrict__ Qp, int ldq, const bf16* __restrict__ Kp, int ldk,
                                          const bf16* __restrict__ Vp, int ldv, bf16* __restrict__ Op, int ldo, int q0, int tid, int wave, int lane) {
    constexpr int DK = SBK ? 128 : 192, NST = DK / 16, KROW = DK * 2 + 16, KCH = DK / 8, NKI = (64 * KCH) / 512;
    asm volatile("" : "+v"(tid), "+v"(lane));
    const int ql = lane & 31, hi = lane >> 5, qw0 = q0 + 32 * wave, myq = qw0 + ql;
    const int nt = (q0 + 256) / 64;
    bf16x8 qf[NST];
    { const bf16* qrow = Qp + (size_t)myq * ldq + 8 * hi;
#pragma unroll
      for (int st = 0; st < NST; ++st) qf[st] = *(const bf16x8*)(qrow + 16 * st); }
    unsigned kgo[NKI], kls[NKI], vgo[2], vls[2];
#pragma unroll
    for (int i = 0; i < NKI; ++i) { const int c = tid + 512 * i, row = c / KCH, cc = c % KCH; kgo[i] = (unsigned)(row * ldk + cc * 8); kls[i] = (unsigned)(row * KROW + cc * 16); }
#pragma unroll
    for (int i = 0; i < 2; ++i) { const int c = tid + 512 * i, row = c >> 4, cc = c & 15; vgo[i] = (unsigned)(row * ldv + cc * 8); vls[i] = (unsigned)(row * AT_VROW + cc * 16); }
    u32x4 kr[NKI], vr[2];
#define AT_LOAD(j) do { const bf16* kp_ = Kp + (size_t)(64 * (j)) * ldk; const bf16* vp_ = Vp + (size_t)(64 * (j)) * ldv; \
        _Pragma("unroll") for (int i = 0; i < NKI; ++i) kr[i] = *(const u32x4*)(kp_ + kgo[i]); \
        _Pragma("unroll") for (int i = 0; i < 2; ++i) vr[i] = *(const u32x4*)(vp_ + vgo[i]); } while (0)
#define AT_STORE(b) do { LAS unsigned char* kb_ = lds + ((b) ? AT_K1 : AT_K0); LAS unsigned char* vb_ = lds + ((b) ? AT_V1 : AT_V0); \
        _Pragma("unroll") for (int i = 0; i < NKI; ++i) *(LAS u32x4*)(kb_ + kls[i]) = kr[i]; \
        _Pragma("unroll") for (int i = 0; i < 2; ++i) *(LAS u32x4*)(vb_ + vls[i]) = vr[i]; } while (0)
    f32x16 o[4];
#pragma unroll
    for (int d = 0; d < 4; ++d)
#pragma unroll
        for (int i = 0; i < 16; ++i) o[d][i] = 0.f;
    float m_run = -INFINITY, l_run = 0.f, carry = 0.f;
    const float qk_scale = SBK ? 0.08838834764831845f : 0.07216878364870323f;
    const float c2 = qk_scale * 1.4426950408889634f;
    const unsigned koff = (unsigned)(ql * KROW + hi * 16);
    const unsigned voff = (unsigned)((4 * hi + ((lane >> 2) & 3)) * AT_VROW + (16 * ((lane >> 4) & 1) + 4 * (lane & 3)) * 2);

    LAS unsigned* dcnt = (LAS unsigned*)(lds + AT_CNT);
    bool wdone = false;
    if (SBK && tid == 0) { dcnt[0] = 0u; dcnt[1] = 0u; dcnt[2] = 0u; }
    __syncthreads();
    { const int j0 = SBK ? nt - 1 : 0; AT_LOAD(j0); AT_STORE(0); }
    __syncthreads();
#pragma unroll 1
    for (int jj = 0; jj < nt; ++jj) {
        const int j = SBK ? nt - 1 - jj : jj, k0 = 64 * j, b = jj & 1;
        const bool more = (jj + 1 < nt);
        if (more) { const int jn = SBK ? j - 1 : j + 1; AT_LOAD(jn); }
        const bool active = SBK ? (k0 < qw0 + 31 && !wdone) : (k0 <= qw0 + 31);
        if (active) {
            const LAS unsigned char* kb = lds + (b ? AT_K1 : AT_K0) + koff;
            f32x16 s0, s1;
#pragma unroll
            for (int i = 0; i < 16; ++i) { s0[i] = 0.f; s1[i] = 0.f; }
#pragma unroll
            for (int st = 0; st < NST; ++st) {
                const bf16x8 a0 = *(const LAS bf16x8*)(kb + st * 32), a1 = *(const LAS bf16x8*)(kb + 32 * KROW + st * 32);
                s0 = __builtin_amdgcn_mfma_f32_32x32x16_bf16(a0, qf[st], s0, 0, 0, 0);
                s1 = __builtin_amdgcn_mfma_f32_32x32x16_bf16(a1, qf[st], s1, 0, 0, 0);
                if ((st & 3) == 3) __builtin_amdgcn_sched_barrier(0);
            }
            if (!SBK) {
                const bool need_mask = (k0 + 63 > qw0);
                if (need_mask) {
#pragma unroll
                    for (int i = 0; i < 16; ++i) { const int key = k0 + crow(i, hi); if (key > myq) s0[i] = -INFINITY; if (key + 32 > myq) s1[i] = -INFINITY; }
                }
                float mx = s0[0];
#pragma unroll
                for (int i = 1; i < 16; ++i) mx = fmaxf(mx, s0[i]);
#pragma unroll
                for (int i = 0; i < 16; ++i) mx = fmaxf(mx, s1[i]);
                mx = fmaxf(mx, __shfl_xor(mx, 32));
                const float m_new = fmaxf(m_run, mx);
                const float alpha = __builtin_amdgcn_exp2f((m_run - m_new) * c2);
                m_run = m_new;
                const float mc = m_new * c2;
                float ls = 0.f;
#pragma unroll
                for (int i = 0; i < 16; ++i) { s0[i] = __builtin_amdgcn_exp2f(s0[i] * c2 - mc); ls += s0[i]; }
#pragma unroll
                for (int i = 0; i < 16; ++i) { s1[i] = __builtin_amdgcn_exp2f(s1[i] * c2 - mc); ls += s1[i]; }
                l_run = l_run * alpha + ls;
#pragma unroll
                for (int d = 0; d < 4; ++d)
#pragma unroll
                    for (int i = 0; i < 16; ++i) o[d][i] *= alpha;
            } else {
                const bool need_mask = (k0 + 63 >= qw0);
                float lomv[32], own[8], par[8];
#pragma unroll
                for (int sub = 0; sub < 2; ++sub)
#pragma unroll
                    for (int i = 0; i < 16; ++i) {
                        const float z = (sub ? s1[i] : s0[i]) * qk_scale;
                        const float e = __builtin_amdgcn_exp2f(-fabsf(z) * 1.4426950408889634f);
                        float lom = -(fmaxf(z, 0.f) + __builtin_amdgcn_logf(1.0f + e) * 0.6931471805599453f);
                        float lb = z + lom;
                        if (need_mask) { const int key = k0 + 32 * sub + crow(i, hi); if (key >= myq) { lom = 0.f; lb = -INFINITY; } }
                        lomv[16 * sub + i] = lom;
                        if (sub) s1[i] = lb; else s0[i] = lb;
                    }
#pragma unroll
                for (int m = 0; m < 8; ++m) { own[m] = (lomv[4 * m] + lomv[4 * m + 1]) + (lomv[4 * m + 2] + lomv[4 * m + 3]); par[m] = __shfl_xor(own[m], 32); }
                float Tm = 0.f;
#pragma unroll
                for (int m = 7; m >= 0; --m) {
                    float run = Tm + carry + (hi == 0 ? par[m] : 0.f);
#pragma unroll
                    for (int r = 3; r >= 0; --r) {
                        const int idx = 4 * m + r;
                        const float lb = (idx >= 16) ? s1[idx - 16] : s0[idx];
                        const float a = __builtin_amdgcn_exp2f((lb + run) * 1.4426950408889634f);
                        if (idx >= 16) s1[idx - 16] = a; else s0[idx] = a;
                        run += lomv[idx];
                    }
                    Tm += own[m] + par[m];
                }
                carry += Tm;
            }
            unsigned pk[16];
#pragma unroll
            for (int js = 0; js < 2; ++js)
#pragma unroll
                for (int w = 0; w < 4; ++w) { pk[4 * js + w] = cvt_pk(s0[8 * js + 2 * w], s0[8 * js + 2 * w + 1]); pk[8 + 4 * js + w] = cvt_pk(s1[8 * js + 2 * w], s1[8 * js + 2 * w + 1]); }
            const LAS unsigned char* vb = lds + (b ? AT_V1 : AT_V0) + voff;
#pragma unroll
            for (int dt = 0; dt < 4; ++dt) {
                __builtin_amdgcn_sched_barrier(0);
#pragma unroll
                for (int ks = 0; ks < 4; ++ks) {
                    const s16x4 lo = vtr(vb + (16 * ks) * AT_VROW + dt * 64), h4 = vtr(vb + (16 * ks + 8) * AT_VROW + dt * 64);
                    const bf16x8 A = (bf16x8){lo[0], lo[1], lo[2], lo[3], h4[0], h4[1], h4[2], h4[3]};
                    const u32x4 pw = (u32x4){pk[4 * ks], pk[4 * ks + 1], pk[4 * ks + 2], pk[4 * ks + 3]};
                    o[dt] = __builtin_amdgcn_mfma_f32_32x32x16_bf16(A, __builtin_bit_cast(bf16x8, pw), o[dt], 0, 0, 0);
                }
            }
        }
        if (SBK) {
            if (!wdone && k0 < qw0 + 31) wdone = __all(carry < -104.0f);
            if (wdone && lane == 0) __hip_atomic_fetch_add(dcnt + (jj % 3), 1u, __ATOMIC_RELAXED, __HIP_MEMORY_SCOPE_WORKGROUP);
        }
        if (more) AT_STORE(b ^ 1);
        __syncthreads();
        if (SBK) {
            if (tid == 0) dcnt[(jj + 2) % 3] = 0u;
            if (dcnt[jj % 3] == 8u) break;
        }
    }
#undef AT_LOAD
#undef AT_STORE
    float inv = 1.0f;
    if (!SBK) { const float lt = l_run + __shfl_xor(l_run, 32); inv = 1.0f / lt; }
    bf16* orow = Op + (size_t)myq * ldo + 4 * hi;
#pragma unroll
    for (int dt = 0; dt < 4; ++dt)
#pragma unroll
        for (int gi = 0; gi < 4; ++gi) {
            u32x2 w; w.x = cvt_pk(o[dt][4 * gi] * inv, o[dt][4 * gi + 1] * inv); w.y = cvt_pk(o[dt][4 * gi + 2] * inv, o[dt][4 * gi + 3] * inv);
            *(u32x2*)(orow + 32 * dt + 8 * gi) = w;
        }
}

struct Args {
    const float *x, *c; const int* pos; const float *w_ada, *b_ada, *g1, *g2, *w_in, *g_ql, *g_kvl, *w_uq, *w_ukv, *g_qh, *g_kh, *w_pa, *w_pb, *w_out, *w_fi, *w_fo;
    float* out; unsigned char* ws;
};

__device__ __forceinline__ void transpose_item(const float* __restrict__ W, int K, int N, bf16* __restrict__ WT, int k0, int n0, int dest_row0, const float* __restrict__ kgain, LAS float* scr, int lane) {
#pragma unroll 8
    for (int i = 0; i < 32; ++i) { const int kk = 2 * i + (lane >> 5); float v = W[(size_t)(k0 + kk) * N + n0 + (lane & 31)]; if (kgain) v *= kgain[k0 + kk]; scr[kk * 33 + (lane & 31)] = v; }
    asm volatile("s_waitcnt lgkmcnt(0)" ::: "memory");
    const int c = lane & 7;
#pragma unroll
    for (int j = 0; j < 4; ++j) { const int n = (lane >> 3) + 8 * j; const LAS float* s = scr + (8 * c) * 33 + n;
        u32x4 o; o.x = cvt_pk(s[0 * 33], s[1 * 33]); o.y = cvt_pk(s[2 * 33], s[3 * 33]); o.z = cvt_pk(s[4 * 33], s[5 * 33]); o.w = cvt_pk(s[6 * 33], s[7 * 33]);
        *(u32x4*)(WT + (size_t)(dest_row0 + n) * K + k0 + 8 * c) = o; }
    asm volatile("s_waitcnt lgkmcnt(0)" ::: "memory");
}

__device__ __forceinline__ void p0_prologue(const Args& a, LAS unsigned char* lds, int gw, int NGW, int wave, int lane) {
    unsigned char* ws = a.ws;
    float* part = (float*)(ws + WS_KVRAW);
    for (int it = gw; it < 48 * NPART; it += NGW) {
        const int cgp = it % 48, kc = it / 48;
        float sv[4];
#pragma unroll
        for (int b = 0; b < 4; ++b) { const float cv = a.c[b * DM + kc * 64 + lane]; sv[b] = cv * fast_sigmoid(cv); }
        f32x4 acc[4];
#pragma unroll
        for (int b = 0; b < 4; ++b) acc[b] = (f32x4){0.f, 0.f, 0.f, 0.f};
        const float* wp = a.w_ada + (size_t)(kc * 64) * ADA_N + cgp * 256 + lane * 4;
#pragma unroll 8
        for (int kk = 0; kk < 64; ++kk) {
            const f32x4 w = *(const f32x4*)(wp + (size_t)kk * ADA_N);
#pragma unroll
            for (int b = 0; b < 4; ++b) { const float s = __uint_as_float(__builtin_amdgcn_readlane(__float_as_uint(sv[b]), kk)); acc[b] += w * s; }
        }
#pragma unroll
        for (int b = 0; b < 4; ++b) *(f32x4*)(part + (size_t)(kc * 4 + b) * ADA_N + cgp * 256 + lane * 4) = acc[b];
    }
    LAS float* scr = (LAS float*)(lds + wave * 8704);
    bf16* Win = (bf16*)(ws + WS_WIN); bf16* Wuq = (bf16*)(ws + WS_WUQ); bf16* Wukv = (bf16*)(ws + WS_WUKV); bf16* Wpa = (bf16*)(ws + WS_WPA); bf16* Wpb = (bf16*)(ws + WS_WPB);
    bf16* Wout = (bf16*)(ws + WS_WOUT); bf16* Wfi = (bf16*)(ws + WS_WFI); bf16* Wfo = (bf16*)(ws + WS_WFO);
    constexpr int I_IN = (DM / 64) * (DIN / 32), I_UQ = (512 / 64) * (1536 / 32), I_UKV = (512 / 64) * (2048 / 32), I_P = (1024 / 64) * (DM / 32), I_OUT = (DM / 64) * (DM / 32),
                  I_FI = (DM / 64) * (2 * DFF / 32), I_FO = (DFF / 64) * (DM / 32);
    constexpr int NITEMS = I_IN + I_UQ + I_UKV + 2 * I_P + I_OUT + I_FI + I_FO;
    for (int it = gw; it < NITEMS; it += NGW) {
        int r = it;
        if (r < I_FI) { const int nblk = 2 * DFF / 32, kb = r / nblk, nb = r % nblk; const int n0 = 32 * nb; const int jn = n0 < DFF ? n0 : n0 - DFF;
            const int dest = 256 * (jn / 128) + (jn % 128) + (n0 < DFF ? 0 : 128);
            transpose_item(a.w_fi, DM, 2 * DFF, Wfi, 64 * kb, n0, dest, nullptr, scr, lane); continue; } r -= I_FI;
        if (r < I_IN) { const int nblk = DIN / 32, kb = r / nblk, nb = r % nblk; const int n0 = 32 * nb; const int dest = n0 < 1088 ? n0 : n0 + 192;
            transpose_item(a.w_in, DM, DIN, Win, 64 * kb, n0, dest, nullptr, scr, lane); continue; } r -= I_IN;
        if (r < I_FO) { const int nblk = DM / 32, kb = r / nblk, nb = r % nblk; transpose_item(a.w_fo, DFF, DM, Wfo, 64 * kb, 32 * nb, 32 * nb, nullptr, scr, lane); continue; } r -= I_FO;
        if (r < I_OUT) { const int nblk = DM / 32, kb = r / nblk, nb = r % nblk; transpose_item(a.w_out, DM, DM, Wout, 64 * kb, 32 * nb, 32 * nb, nullptr, scr, lane); continue; } r -= I_OUT;
        if (r < I_P) { const int nblk = DM / 32, kb = r / nblk, nb = r % nblk; transpose_item(a.w_pa, 1024, DM, Wpa, 64 * kb, 32 * nb, 32 * nb, nullptr, scr, lane); continue; } r -= I_P;
        if (r < I_P) { const int nblk = DM / 32, kb = r / nblk, nb = r % nblk; transpose_item(a.w_pb, 1024, DM, Wpb, 64 * kb, 32 * nb, 32 * nb, nullptr, scr, lane); continue; } r -= I_P;
        if (r < I_UQ) { const int nblk = 1536 / 32, kb = r / nblk, nb = r % nblk; transpose_item(a.w_uq, 512, 1536, Wuq, 64 * kb, 32 * nb, 32 * nb, a.g_ql, scr, lane); continue; } r -= I_UQ;
        { const int nblk = 2048 / 32, kb = r / nblk, nb = r % nblk; transpose_item(a.w_ukv, 512, 2048, Wukv, 64 * kb, 32 * nb, 32 * nb, a.g_kvl, scr, lane); }
    }
    for (int p = gw * 64 + lane; p < 192 * DM / 8; p += NGW * 64) *(u32x4*)(Win + (size_t)1088 * DM + (size_t)p * 8) = (u32x4){0u, 0u, 0u, 0u};
}

__device__ __forceinline__ void norm_rows(const float* __restrict__ src, bf16* __restrict__ dst, const LAS float* scale, const LAS float* shift, int row0, int wave, int lane) {
#pragma unroll 1
    for (int r = 0; r < 8; ++r) {
        const int row = row0 + wave * 8 + r;
        const f32x4* xr = (const f32x4*)(src + (size_t)row * DM) + lane;
        f32x4 v[8]; float ss = 0.f;
#pragma unroll
        for (int j = 0; j < 8; ++j) { v[j] = xr[64 * j]; ss += (v[j].x * v[j].x + v[j].y * v[j].y) + (v[j].z * v[j].z + v[j].w * v[j].w); }
        const float rstd = 1.0f / sqrtf(wave_sum(ss) * (1.0f / DM) + EPS);
        u32x2* orow = (u32x2*)(dst + (size_t)row * DM) + lane;
#pragma unroll
        for (int j = 0; j < 8; ++j) { const int col = 4 * (64 * j + lane); const f32x4 sc = *(const LAS f32x4*)(scale + col), sh = *(const LAS f32x4*)(shift + col);
            const f32x4 y = v[j] * rstd * sc + sh; u32x2 w; w.x = cvt_pk(y.x, y.y); w.y = cvt_pk(y.z, y.w); orow[64 * j] = w; }
    }
}

__global__ void __launch_bounds__(512, 2) fwd_megakernel(Args a) {
    extern __shared__ __attribute__((aligned(16))) unsigned char lds_raw[];
    LAS unsigned char* lds = (LAS unsigned char*)lds_raw;
    cg::grid_group grid = cg::this_grid();
    const int tid = threadIdx.x, lane = tid & 63, wave = __builtin_amdgcn_readfirstlane(tid >> 6);
    const int G = gridDim.x, bx = blockIdx.x;
    const int vcu = (G % 8 == 0) ? (bx % 8) * (G / 8) + bx / 8 : bx;
    const int gw = vcu * 8 + wave, NGW = G * 8;
    unsigned char* ws = a.ws;
    float* ada = (float*)(ws + WS_ADA);
    float* part = (float*)(ws + WS_KVRAW);
    bf16* Win = (bf16*)(ws + WS_WIN); bf16* Wuq = (bf16*)(ws + WS_WUQ); bf16* Wukv = (bf16*)(ws + WS_WUKV); bf16* Wpa = (bf16*)(ws + WS_WPA); bf16* Wpb = (bf16*)(ws + WS_WPB);
    bf16* Wout = (bf16*)(ws + WS_WOUT); bf16* Wfi = (bf16*)(ws + WS_WFI); bf16* Wfo = (bf16*)(ws + WS_WFO);
    bf16* proj = (bf16*)(ws + WS_PROJ); bf16* act = (bf16*)(ws + WS_PROJ);
    bf16* kvraw = (bf16*)(ws + WS_KVRAW); bf16* merged = (bf16*)(ws + WS_KVRAW);
    bf16* ybuf = (bf16*)(ws + WS_Y); bf16* h2 = (bf16*)(ws + WS_Y);
    bf16* hbuf = (bf16*)a.out; bf16* qbuf = (bf16*)a.out; bf16* kbuf = (bf16*)((unsigned char*)a.out + DO_K);
    LAS float* tscale = (LAS float*)lds; LAS float* tshift = (LAS float*)(lds + 8192);

    p0_prologue(a, lds, gw, NGW, wave, lane);
    grid.sync();

    for (int e = bx * 512 + tid; e < NB * ADA_N; e += G * 512) { const int b = e / ADA_N, n = e % ADA_N; float v = a.b_ada[n];
        for (int p = 0; p < NPART; ++p) v += part[(size_t)(p * 4 + b) * ADA_N + n];
        ada[e] = v; }
    for (int ch = bx; ch < T / 64; ch += G) {
        const int b = (ch * 64) / SEQ;
        __syncthreads();
        for (int d = tid; d < DM; d += 512) { float sh = a.b_ada[d], sc = a.b_ada[DM + d];
            for (int p = 0; p < NPART; ++p) { sh += part[(size_t)(p * 4 + b) * ADA_N + d]; sc += part[(size_t)(p * 4 + b) * ADA_N + DM + d]; }
            tscale[d] = a.g1[d] * (1.0f + sc); tshift[d] = sh; }
        __syncthreads();
        norm_rows(a.x, hbuf, tscale, tshift, ch * 64, wave, lane);
    }
    grid.sync();

    { pg8::Gemm g{hbuf, Win, T, PLD, DM, DM, DM}; pg8::StaticOrder S; S.init(T, PLD, G, bx); pg8::EpiBf16 E{proj, PLD}; pg8::gemm_phase(lds, g, S, E); }
    grid.sync();

    { pg8::Gemm g{proj, Wuq, T, 1536, 512, PLD, 512}; pg8::StaticOrder S; S.init(T, 1536, G, bx); pg8::EpiBf16 E{qbuf, 1536}; pg8::gemm_phase(lds, g, S, E); }
    { pg8::Gemm g{proj + 512, Wukv, T, 2048, 512, PLD, 512}; pg8::StaticOrder S; S.init(T, 2048, G, bx); pg8::EpiBf16 E{kvraw, 2048}; pg8::gemm_phase(lds, g, S, E); }
    grid.sync();

    for (int t = gw; t < T; t += NGW) {
        const bf16* prow = proj + (size_t)t * PLD;
        float aq, akv;
        { const u32x4 u = *(const u32x4*)(prow + lane * 8); float s = bf_lo(u.x) * bf_lo(u.x) + bf_hi(u.x) * bf_hi(u.x) + bf_lo(u.y) * bf_lo(u.y) + bf_hi(u.y) * bf_hi(u.y)
              + bf_lo(u.z) * bf_lo(u.z) + bf_hi(u.z) * bf_hi(u.z) + bf_lo(u.w) * bf_lo(u.w) + bf_hi(u.w) * bf_hi(u.w);
          aq = 1.0f / sqrtf(wave_sum(s) * (1.0f / 512.0f) + EPS); }
        { const u32x4 u = *(const u32x4*)(prow + 512 + lane * 8); float s = bf_lo(u.x) * bf_lo(u.x) + bf_hi(u.x) * bf_hi(u.x) + bf_lo(u.y) * bf_lo(u.y) + bf_hi(u.y) * bf_hi(u.y)
              + bf_lo(u.z) * bf_lo(u.z) + bf_hi(u.z) * bf_hi(u.z) + bf_lo(u.w) * bf_lo(u.w) + bf_hi(u.w) * bf_hi(u.w);
          akv = 1.0f / sqrtf(wave_sum(s) * (1.0f / 512.0f) + EPS); }
        const float kpe = bf2f(prow[C_KPE + lane]);
        const float ang = (float)a.pos[t] * ROPE_FREQ[lane & 31];
        double rev = (double)ang * 0.15915494309189535; rev -= __builtin_rint(rev);
        const float sn = __builtin_amdgcn_sinf((float)rev), cs = __builtin_amdgcn_cosf((float)rev);
        const float gq0 = a.g_qh[lane], gq1 = a.g_qh[64 + lane], gq2 = a.g_qh[128 + lane];
        const float gk0 = a.g_kh[lane], gk1 = a.g_kh[64 + lane], gk2 = a.g_kh[128 + lane];
        bf16* qrow = qbuf + (size_t)t * 1536; bf16* krow = kbuf + (size_t)t * 1536; bf16* kvrow = kvraw + (size_t)t * 2048;
#pragma unroll 2
        for (int h = 0; h < NH; ++h) {
            { bf16* qh = qrow + h * DQK;
              const float e0 = bf2f(qh[lane]) * aq, e1 = bf2f(qh[64 + lane]) * aq, e2 = bf2f(qh[128 + lane]) * aq;
              const float rstd = 1.0f / sqrtf(wave_sum(e0 * e0 + e1 * e1 + e2 * e2) * (1.0f / DQK) + EPS);
              const float f2 = e2 * rstd * gq2, pf = __shfl_xor(f2, 32);
              const float rot = lane < 32 ? f2 * cs - pf * sn : pf * sn + f2 * cs;
              qh[lane] = f2bf(e0 * rstd * gq0); qh[64 + lane] = f2bf(e1 * rstd * gq1); qh[128 + lane] = f2bf(rot); }
            { const bf16* kn = kvrow + h * 256; bf16* kh = krow + h * DQK;
              const float e0 = bf2f(kn[lane]) * akv, e1 = bf2f(kn[64 + lane]) * akv, e2 = kpe;
              const float rstd = 1.0f / sqrtf(wave_sum(e0 * e0 + e1 * e1 + e2 * e2) * (1.0f / DQK) + EPS);
              const float f2 = e2 * rstd * gk2, pf = __shfl_xor(f2, 32);
              const float rot = lane < 32 ? f2 * cs - pf * sn : pf * sn + f2 * cs;
              kh[lane] = f2bf(e0 * rstd * gk0); kh[64 + lane] = f2bf(e1 * rstd * gk1); kh[128 + lane] = f2bf(rot); }
            { unsigned* vp = (unsigned*)(kvrow + h * 256 + 128) + lane; const unsigned u = *vp; *vp = cvt_pk(bf_lo(u) * akv, bf_hi(u) * akv); }
        }
    }
    grid.sync();

    for (int su = vcu; su < 256; su += G) {
        const int bh = su >> 3, p = su & 7, b = bh >> 3, h = bh & 7;
        const size_t r0 = (size_t)b * SEQ;
#pragma unroll 1
        for (int half = 0; half < 2; ++half) {
            const int qb = half ? 15 - p : p;
            attn_unit<false>(lds, qbuf + r0 * 1536 + h * DQK, 1536, kbuf + r0 * 1536 + h * DQK, 1536, kvraw + r0 * 2048 + h * 256 + 128, 2048, ybuf + r0 * DM + h * 128, DM, qb * 256, tid, wave, lane);
            attn_unit<true>(lds, proj + r0 * PLD + C_SBQ + h * 128, PLD, proj + r0 * PLD + C_SBK + h * 128, PLD, proj + r0 * PLD + C_SBV + h * 128, PLD, ybuf + r0 * DM + 1024 + h * 128, DM, qb * 256, tid, wave, lane);
        }
    }
    grid.sync();

    { pg8::Gemm g{ybuf, Wpa, T, DM, 1024, DM, 1024}; pg8::StaticOrder S; S.init(T, DM, G, bx); pg8::EpiGate<false> E{merged, DM, proj + C_GA, PLD}; pg8::gemm_phase(lds, g, S, E); }
    { pg8::Gemm g{ybuf + 1024, Wpb, T, DM, 1024, DM, 1024}; pg8::StaticOrder S; S.init(T, DM, G, bx); pg8::EpiGate<true> E{merged, DM, proj + C_GB, PLD}; pg8::gemm_phase(lds, g, S, E); }
    grid.sync();

    { pg8::Gemm g{merged, Wout, T, DM, DM, DM, DM}; pg8::StaticOrder S; S.init(T, DM, G, bx); pg8::EpiRes E{a.x, a.out, ada + 2 * DM, ADA_N}; pg8::gemm_phase(lds, g, S, E); }
    grid.sync();

    for (int ch = bx; ch < T / 64; ch += G) {
        const int b = (ch * 64) / SEQ;
        __syncthreads();
        for (int d = tid; d < DM; d += 512) { tscale[d] = a.g2[d] * (1.0f + ada[b * ADA_N + 4 * DM + d]); tshift[d] = ada[b * ADA_N + 3 * DM + d]; }
        __syncthreads();
        norm_rows(a.out, h2, tscale, tshift, ch * 64, wave, lane);
    }
    grid.sync();

    { pg8::Gemm g{h2, Wfi, T, 2 * DFF, DM, DM, DM}; pg8::StaticOrder S; S.init(T, 2 * DFF, G, bx); pg8::EpiSwiglu E{act, DFF}; pg8::gemm_phase(lds, g, S, E); }
    grid.sync();

    { pg8::Gemm g{act, Wfo, T, DM, DFF, DFF, DFF}; pg8::StaticOrder S; S.init(T, DM, G, bx); pg8::EpiRes E{a.out, a.out, ada + 5 * DM, ADA_N}; pg8::gemm_phase(lds, g, S, E); }
}

constexpr int LDS_BYTES = 147456;
extern "C" void kernel_launch(void* const* d_in, const int* in_sizes, int n_in, void* d_out, int out_size, void* d_ws, size_t ws_size, hipStream_t stream) {
    static int grid = 0;
    if (grid == 0) {
        if (n_in != 19 || out_size != T * DM || ws_size < WS_END) { fprintf(stderr, "kernel_launch: unexpected problem (n_in %d out %d ws %zu)\n", n_in, out_size, ws_size); grid = -1; return; }
        int dev = 0, cus = 0, per_cu = 0;
        hipGetDevice(&dev); hipDeviceGetAttribute(&cus, hipDeviceAttributeMultiprocessorCount, dev);
        if (hipFuncSetAttribute((const void*)fwd_megakernel, hipFuncAttributeMaxDynamicSharedMemorySize, LDS_BYTES) != hipSuccess) { fprintf(stderr, "kernel_launch: hipFuncSetAttribute failed\n"); grid = -1; return; }
        if (hipOccupancyMaxActiveBlocksPerMultiprocessor(&per_cu, (const void*)fwd_megakernel, 512, LDS_BYTES) != hipSuccess || per_cu < 1) { fprintf(stderr, "kernel_launch: occupancy query failed (%d)\n", per_cu); per_cu = 1; }
        (void)hipGetLastError();
        grid = cus * (per_cu > 1 ? 1 : per_cu);
    }
    if (grid < 0) return;
    Args a{};
    a.x = (const float*)d_in[0]; a.c = (const float*)d_in[1]; a.pos = (const int*)d_in[2]; a.w_ada = (const float*)d_in[3]; a.b_ada = (const float*)d_in[4];
    a.g1 = (const float*)d_in[5]; a.g2 = (const float*)d_in[6]; a.w_in = (const float*)d_in[7]; a.g_ql = (const float*)d_in[8]; a.g_kvl = (const float*)d_in[9];
    a.w_uq = (const float*)d_in[10]; a.w_ukv = (const float*)d_in[11]; a.g_qh = (const float*)d_in[12]; a.g_kh = (const float*)d_in[13]; a.w_pa = (const float*)d_in[14];
    a.w_pb = (const float*)d_in[15]; a.w_out = (const float*)d_in[16]; a.w_fi = (const float*)d_in[17]; a.w_fo = (const float*)d_in[18];
    a.out = (float*)d_out; a.ws = (unsigned char*)d_ws;
    void* args[] = {&a};
    hipError_t e = hipLaunchCooperativeKernel((const void*)fwd_megakernel, dim3(grid), dim3(512), args, LDS_BYTES, stream);
    if (e != hipSuccess) fprintf(stderr, "kernel_launch: cooperative launch failed: %s (grid %d)\n", hipGetErrorString(e), grid);
}
```

```cpp
#include <hip/hip_runtime.h>
#include <hip/hip_cooperative_groups.h>
#include <cstdio>
#include <cstdint>
namespace cg = cooperative_groups;

#define LAS __attribute__((address_space(3)))
typedef unsigned short bf16;
typedef short bf16x8 __attribute__((ext_vector_type(8)));
typedef short s16x4 __attribute__((ext_vector_type(4)));
typedef float f32x2 __attribute__((ext_vector_type(2)));
typedef float f32x4 __attribute__((ext_vector_type(4)));
typedef float f32x16 __attribute__((ext_vector_type(16)));
typedef unsigned u32x4 __attribute__((ext_vector_type(4)));
typedef unsigned u32x2 __attribute__((ext_vector_type(2)));
typedef __bf16 bf16x2_t __attribute__((ext_vector_type(2)));

constexpr int NB = 4, SEQ = 4096, T = NB * SEQ, DM = 2048;
constexpr int NH = 8, DQK = 192, DFF = 5632, DIN = 8256, PLD = 8448;
constexpr int C_KPE = 1024, C_SBQ = 1280, C_SBK = 2304, C_SBV = 3328, C_GA = 4352, C_GB = 6400;
constexpr int ADA_N = 6 * DM;
constexpr int NPART = 32;
constexpr float EPS = 1e-6f;
constexpr size_t MiB = 1u << 20;
constexpr size_t WS_BAR = 512 * 1024;
constexpr int LDS_MISC = 131072 + 512;
constexpr size_t WS_ADA = 0;
constexpr size_t WS_WIN = 1 * MiB, WS_WUQ = 34 * MiB, WS_WUKV = 36 * MiB, WS_WPA = 38 * MiB, WS_WPB = 42 * MiB, WS_WOUT = 46 * MiB, WS_WFI = 54 * MiB, WS_WFO = 98 * MiB;
constexpr size_t WS_PROJ = 120 * MiB;
constexpr size_t WS_KVRAW = 384 * MiB;
constexpr size_t WS_Y = 448 * MiB;
constexpr size_t WS_END = 512 * MiB;
constexpr size_t DO_K = 48 * MiB;

__device__ const float ROPE_FREQ[32] = {1.0f, 0.7498942613601685f, 0.5623413324356079f, 0.4216965138912201f, 0.3162277638912201f, 0.23713737726211548f, 0.17782793939113617f, 0.133352130651474f,
    0.10000000149011612f, 0.07498941570520401f, 0.05623413249850273f, 0.04216965287923813f, 0.03162277489900589f, 0.023713737726211548f, 0.017782794311642647f, 0.01333521492779255f,
    0.009999999776482582f, 0.007498941849917173f, 0.005623413249850273f, 0.0042169648222625256f, 0.003162277629598975f, 0.00237137358635664f, 0.0017782794311642647f, 0.0013335214462131262f,
    0.0010000000474974513f, 0.0007498942431993783f, 0.000562341301701963f, 0.0004216965171508491f, 0.0003162277571391314f, 0.00023713737027719617f, 0.00017782794020604342f, 0.0001333521504420787f};

__device__ __forceinline__ unsigned cvt_pk(float lo, float hi) { f32x2 v = {lo, hi}; bf16x2_t b = __builtin_convertvector(v, bf16x2_t); return __builtin_bit_cast(unsigned, b); }
__device__ __forceinline__ float bf_lo(unsigned u) { return __uint_as_float(u << 16); }
__device__ __forceinline__ float bf_hi(unsigned u) { return __uint_as_float(u & 0xffff0000u); }
__device__ __forceinline__ float bf2f(bf16 b) { return __uint_as_float((unsigned)b << 16); }
__device__ __forceinline__ bf16 f2bf(float f) { return (bf16)(cvt_pk(f, 0.f) & 0xffffu); }
__device__ __forceinline__ float wave_sum(float v) {
#pragma unroll
    for (int o = 1; o < 64; o <<= 1) v += __shfl_xor(v, o);
    return v;
}
__device__ __forceinline__ float fast_sigmoid(float x) { return __builtin_amdgcn_rcpf(1.0f + __expf(-x)); }

namespace pg8 {
constexpr int BM = 256, BK = 64, HALF = 128, HTB = HALF * BK * 2, STAGE_BYTES = 8 * HTB, NXCD = 8, WGM = 8;
__host__ __device__ __forceinline__ int lds_byte(int r, int c) { const int st = (r >> 4) * 2 + (c >> 5), rr = r & 15, cc = c & 31, ob = rr * 64 + cc * 2; return st * 1024 + (ob ^ (((ob >> 9) & 1) << 5)); }
__host__ __device__ __forceinline__ void stage_rc(int b, int& R, int& C) { const int st = b / 1024, sb = b % 1024, swz = sb ^ (((sb >> 9) & 1) << 5); R = (st >> 1) * 16 + swz / 64; C = (st & 1) * 32 + (swz % 64) / 2; }
__host__ __device__ __forceinline__ int perm32(int rho) { const int n = rho >> 4, i = rho & 15; return 8 * (i >> 2) + 4 * n + (i & 3); }
struct Unit { int pm, pn; };
struct Gemm { const bf16* A; const bf16* Bt; int M, N, K, lda, ldb; };
struct StaticOrder {
    int nM, nN, nwg, G, c;
    __device__ void init(int M, int N, int G_, int c_) { nM = M / BM; nN = N / BM; nwg = nM * nN; G = G_; c = c_; }
    __device__ bool next(int i, Unit& u) const {
        const long L = (long)i * G + c; if (L >= nwg) return false;
        int wgid = (int)L; { const int q = nwg / NXCD, r = nwg % NXCD, xcd = wgid % NXCD, off = wgid / NXCD; wgid = (xcd < r ? xcd * (q + 1) : r * (q + 1) + (xcd - r) * q) + off; }
        const int nig = WGM * nN, gid = wgid / nig, fm = gid * WGM, gsz = (nM - fm) < WGM ? (nM - fm) : WGM;
        u.pm = fm + ((wgid % nig) % gsz); u.pn = (wgid % nig) / gsz; return true;
    }
};
typedef f32x4 Acc[2][2][4][2];

struct EpiBf16 {
    bf16* O; int ldc;
    __device__ __forceinline__ void operator()(const Acc& acc, const Unit& u, int wr, int wc, int fr, int fq) const {
        const int row0 = u.pm * BM + wr * 64 + fr, col0 = u.pn * BM + wc * 32 + 8 * fq;
#pragma unroll
        for (int ai = 0; ai < 2; ++ai)
#pragma unroll
            for (int m = 0; m < 4; ++m) { bf16* rowp = O + (size_t)(row0 + ai * HALF + m * 16) * ldc + col0;
#pragma unroll
                for (int bj = 0; bj < 2; ++bj) { const f32x4 v0 = acc[ai][bj][m][0], v1 = acc[ai][bj][m][1];
                    u32x4 w; w.x = cvt_pk(v0[0], v0[1]); w.y = cvt_pk(v0[2], v0[3]); w.z = cvt_pk(v1[0], v1[1]); w.w = cvt_pk(v1[2], v1[3]);
                    *(u32x4*)(rowp + bj * HALF) = w; } }
    }
};
template <bool ACCUM> struct EpiGate {
    bf16* O; int ldc; const bf16* gate; int ldg;
    __device__ __forceinline__ void operator()(const Acc& acc, const Unit& u, int wr, int wc, int fr, int fq) const {
        const int row0 = u.pm * BM + wr * 64 + fr, col0 = u.pn * BM + wc * 32 + 8 * fq;
#pragma unroll
        for (int ai = 0; ai < 2; ++ai)
#pragma unroll
            for (int m = 0; m < 4; ++m) { const size_t row = (size_t)(row0 + ai * HALF + m * 16);
#pragma unroll
                for (int bj = 0; bj < 2; ++bj) {
                    const u32x4 g = *(const u32x4*)(gate + row * ldg + col0 + bj * HALF);
                    const f32x4 v0 = acc[ai][bj][m][0], v1 = acc[ai][bj][m][1];
                    float r[8];
                    r[0] = v0[0] * fast_sigmoid(bf_lo(g.x)); r[1] = v0[1] * fast_sigmoid(bf_hi(g.x)); r[2] = v0[2] * fast_sigmoid(bf_lo(g.y)); r[3] = v0[3] * fast_sigmoid(bf_hi(g.y));
                    r[4] = v1[0] * fast_sigmoid(bf_lo(g.z)); r[5] = v1[1] * fast_sigmoid(bf_hi(g.z)); r[6] = v1[2] * fast_sigmoid(bf_lo(g.w)); r[7] = v1[3] * fast_sigmoid(bf_hi(g.w));
                    bf16* op = O + row * ldc + col0 + bj * HALF;
                    if (ACCUM) { const u32x4 o = *(const u32x4*)op;
                        r[0] += bf_lo(o.x); r[1] += bf_hi(o.x); r[2] += bf_lo(o.y); r[3] += bf_hi(o.y); r[4] += bf_lo(o.z); r[5] += bf_hi(o.z); r[6] += bf_lo(o.w); r[7] += bf_hi(o.w); }
                    u32x4 w; w.x = cvt_pk(r[0], r[1]); w.y = cvt_pk(r[2], r[3]); w.z = cvt_pk(r[4], r[5]); w.w = cvt_pk(r[6], r[7]);
                    *(u32x4*)op = w; } }
    }
};
struct EpiRes {
    const float* base; float* out; const float* gt; int gt_ld;
    __device__ __forceinline__ void operator()(const Acc& acc, const Unit& u, int wr, int wc, int fr, int fq) const {
        const int row0 = u.pm * BM + wr * 64 + fr, col0 = u.pn * BM + wc * 32 + 8 * fq;
        const float* gp = gt + (size_t)((u.pm * BM) / SEQ) * gt_ld + col0;
        f32x4 gv[2][2];
#pragma unroll
        for (int bj = 0; bj < 2; ++bj)
#pragma unroll
            for (int n = 0; n < 2; ++n) gv[bj][n] = *(const f32x4*)(gp + bj * HALF + 4 * n);
#pragma unroll
        for (int ai = 0; ai < 2; ++ai)
#pragma unroll
            for (int m = 0; m < 4; ++m) { const size_t off = (size_t)(row0 + ai * HALF + m * 16) * DM + col0;
#pragma unroll
                for (int bj = 0; bj < 2; ++bj)
#pragma unroll
                    for (int n = 0; n < 2; ++n) { const f32x4 b = *(const f32x4*)(base + off + bj * HALF + 4 * n);
                        *(f32x4*)(out + off + bj * HALF + 4 * n) = b + gv[bj][n] * acc[ai][bj][m][n]; } }
    }
};
struct EpiSwiglu {
    bf16* O; int ldc;
    __device__ __forceinline__ void operator()(const Acc& acc, const Unit& u, int wr, int wc, int fr, int fq) const {
        const int row0 = u.pm * BM + wr * 64 + fr, col0 = u.pn * HALF + wc * 32 + 8 * fq;
#pragma unroll
        for (int ai = 0; ai < 2; ++ai)
#pragma unroll
            for (int m = 0; m < 4; ++m) { float r[8];
#pragma unroll
                for (int n = 0; n < 2; ++n)
#pragma unroll
                    for (int e = 0; e < 4; ++e) { const float g = acc[ai][0][m][n][e], up = acc[ai][1][m][n][e]; r[4 * n + e] = g * fast_sigmoid(g) * up; }
                u32x4 w; w.x = cvt_pk(r[0], r[1]); w.y = cvt_pk(r[2], r[3]); w.z = cvt_pk(r[4], r[5]); w.w = cvt_pk(r[6], r[7]);
                *(u32x4*)(O + (size_t)(row0 + ai * HALF + m * 16) * ldc + col0) = w; }
    }
};

template <class Epi>
__device__ __forceinline__ void gemm_phase(LAS unsigned char* lds, const Gemm g, const StaticOrder& S, const Epi& E) {
    int tid = threadIdx.x;
    asm volatile("" : "+v"(tid));
    const int wid = __builtin_amdgcn_readfirstlane(tid >> 6), lane = tid & 63, wr = wid >> 2, wc = wid & 3, fr = lane & 15, fq = lane >> 4;
    const int K = g.K, nt = K / BK;
    unsigned voffA[2], voffB[2];
#pragma unroll
    for (int i = 0; i < 2; ++i) { int R, C; stage_rc(tid * 16 + i * 8192, R, C); const int Rb = (R & ~31) + perm32(R & 31);
        voffA[i] = (unsigned)(R * g.lda + C) * 2u; voffB[i] = (unsigned)(Rb * g.ldb + C) * 2u; }
    const size_t kstep = (size_t)(BK * 2);
    const size_t hstepA = (size_t)HALF * g.lda * 2, hstepB = (size_t)HALF * g.ldb * 2;
    const size_t tstepA = 2 * hstepA, tstepB = 2 * hstepB;
    const unsigned ldsw = (unsigned)wid * 1024u;
    const int aoff = lds_byte(wr * 64 + fr, fq * 8), boff = lds_byte(wc * 32 + fr, fq * 8);
#define PG8_SA(b, h) (((b) * 2 + (h)) * HTB)
#define PG8_SB(b, h) ((4 + (b) * 2 + (h)) * HTB)
#define PG8_STAGE(bufoff, gbase, voff) do { _Pragma("unroll") for (int _i = 0; _i < 2; ++_i) \
        __builtin_amdgcn_global_load_lds((const unsigned*)((const char*)(gbase) + (voff)[_i]), (LAS unsigned*)(lds + (bufoff) + ldsw + _i * 8192), 16, 0, 0); } while (0)
#define PG8_LDA(dst, b, h) do { _Pragma("unroll") for (int m = 0; m < 4; ++m) _Pragma("unroll") for (int k = 0; k < 2; ++k) dst[m][k] = *(const LAS bf16x8*)(lds + PG8_SA(b, h) + aoff + m * 2048 + k * 1024); } while (0)
#define PG8_LDB(dst, b, h) do { _Pragma("unroll") for (int n = 0; n < 2; ++n) _Pragma("unroll") for (int k = 0; k < 2; ++k) dst[n][k] = *(const LAS bf16x8*)(lds + PG8_SB(b, h) + boff + n * 2048 + k * 1024); } while (0)
#define PG8_MMA(ai, bj, At, Bt) do { __builtin_amdgcn_s_setprio(1); _Pragma("unroll") for (int m = 0; m < 4; ++m) _Pragma("unroll") for (int n = 0; n < 2; ++n) _Pragma("unroll") for (int k = 0; k < 2; ++k) \
        acc[ai][bj][m][n] = __builtin_amdgcn_mfma_f32_16x16x32_bf16(Bt[n][k], At[m][k], acc[ai][bj][m][n], 0, 0, 0); __builtin_amdgcn_s_setprio(0); } while (0)
#define PG8_WAIT_V(n) asm volatile("s_waitcnt vmcnt(" #n ")" ::: "memory")
#define PG8_WAIT_L(n) asm volatile("s_waitcnt lgkmcnt(" #n ")" ::: "memory")
#define PG8_BAR __builtin_amdgcn_s_barrier()
#define PG8_SCHED __builtin_amdgcn_sched_barrier(0)
    Unit cur, nxt; int ui = 0;
    if (!S.next(0, cur)) return;
    Acc acc;
#pragma unroll
    for (int a = 0; a < 2; ++a)
#pragma unroll
        for (int b = 0; b < 2; ++b)
#pragma unroll
            for (int m = 0; m < 4; ++m)
#pragma unroll
                for (int n = 0; n < 2; ++n) acc[a][b][m][n] = (f32x4){0.f, 0.f, 0.f, 0.f};
    bf16x8 At[4][2], B0[2][2], B1[2][2];
    const char* cA = (const char*)g.A + (size_t)cur.pm * tstepA; const char* cB = (const char*)g.Bt + (size_t)cur.pn * tstepB;
    PG8_STAGE(PG8_SB(0, 0), cB, voffB); PG8_STAGE(PG8_SB(0, 1), cB + hstepB, voffB); PG8_STAGE(PG8_SA(0, 0), cA, voffA); PG8_STAGE(PG8_SA(0, 1), cA + hstepA, voffA);
    if (wr == 1) PG8_BAR;
    PG8_WAIT_V(2); PG8_BAR;
    PG8_STAGE(PG8_SB(1, 0), cB + kstep, voffB); PG8_STAGE(PG8_SA(1, 0), cA + kstep, voffA); PG8_STAGE(PG8_SB(1, 1), cB + hstepB + kstep, voffB);
    PG8_WAIT_V(6); PG8_BAR;
    for (;;) {
        const bool has_next = S.next(ui + 1, nxt);
        const char* nA = has_next ? (const char*)g.A + (size_t)nxt.pm * tstepA : cA; const char* nB = has_next ? (const char*)g.Bt + (size_t)nxt.pn * tstepB : cB;
        for (int t = 0; t < nt; t += 2) {
            const bool last = (t == nt - 2);
            const char* a1 = cA + (size_t)(t + 1) * kstep;
            const char* a2 = last ? nA : cA + (size_t)(t + 2) * kstep; const char* b2 = last ? nB : cB + (size_t)(t + 2) * kstep;
            const char* a3 = a2 + kstep; const char* b3 = b2 + kstep;
            PG8_LDB(B0, 0, 0); PG8_LDB(B1, 0, 1); PG8_SCHED; PG8_LDA(At, 0, 0); PG8_STAGE(PG8_SA(1, 1), a1 + hstepA, voffA);
            PG8_WAIT_V(8); PG8_WAIT_L(0); PG8_BAR; PG8_MMA(0, 0, At, B0); PG8_MMA(0, 1, At, B1); PG8_BAR; PG8_SCHED;
            PG8_LDA(At, 0, 1); PG8_STAGE(PG8_SB(0, 0), b2, voffB); PG8_STAGE(PG8_SB(0, 1), b2 + hstepB, voffB); PG8_STAGE(PG8_SA(0, 0), a2, voffA);
            PG8_WAIT_V(8); PG8_WAIT_L(0); PG8_BAR; PG8_MMA(1, 0, At, B0); PG8_MMA(1, 1, At, B1); PG8_BAR; PG8_SCHED;
            PG8_LDB(B0, 1, 0); PG8_LDB(B1, 1, 1); PG8_SCHED; PG8_LDA(At, 1, 0); PG8_STAGE(PG8_SA(0, 1), a2 + hstepA, voffA);
            PG8_WAIT_V(8); PG8_WAIT_L(0); PG8_BAR; PG8_MMA(0, 0, At, B0); PG8_MMA(0, 1, At, B1); PG8_BAR; PG8_SCHED;
            PG8_LDA(At, 1, 1); PG8_STAGE(PG8_SB(1, 0), b3, voffB); PG8_STAGE(PG8_SB(1, 1), b3 + hstepB, voffB); PG8_STAGE(PG8_SA(1, 0), a3, voffA);
            PG8_WAIT_V(8); PG8_WAIT_L(0); PG8_BAR; PG8_MMA(1, 0, At, B0); PG8_MMA(1, 1, At, B1); PG8_BAR; PG8_SCHED;
        }
        if (wr == 0) PG8_BAR;
        E(acc, cur, wr, wc, fr, fq);
        if (!has_next) break;
#pragma unroll
        for (int a = 0; a < 2; ++a)
#pragma unroll
            for (int b = 0; b < 2; ++b)
#pragma unroll
                for (int m = 0; m < 4; ++m)
#pragma unroll
                    for (int n = 0; n < 2; ++n) acc[a][b][m][n] = (f32x4){0.f, 0.f, 0.f, 0.f};
        cur = nxt; cA = nA; cB = nB; ++ui;
        if (wr == 1) PG8_BAR;
    }
    PG8_WAIT_V(0);
    PG8_BAR;
#undef PG8_SA
#undef PG8_SB
#undef PG8_STAGE
#undef PG8_LDA
#undef PG8_LDB
#undef PG8_MMA
#undef PG8_WAIT_V
#undef PG8_WAIT_L
#undef PG8_BAR
#undef PG8_SCHED
}
}

__device__ __forceinline__ int crow(int r, int hi) { return (r & 3) + 8 * (r >> 2) + 4 * hi; }
__device__ __forceinline__ s16x4 vtr(const LAS unsigned char* p) { typedef short v4i16_t __attribute__((ext_vector_type(4)));
    return __builtin_bit_cast(s16x4, __builtin_amdgcn_ds_read_tr16_b64_v4i16((LAS v4i16_t*)p)); }
constexpr int AT_K0 = 0, AT_K1 = 25600, AT_V0 = 51200, AT_V1 = 71680, AT_VROW = 320, AT_CNT = 92160;

template <bool SBK>
__device__ __forceinline__ void attn_unit(LAS unsigned char* lds, const bf16* __restrict__ Qp, int ldq, const bf16* __restrict__ Kp, int ldk,
                                          const bf16* __restrict__ Vp, int ldv, bf16* __restrict__ Op, int ldo, int q0, int tid, int wave, int lane) {
    constexpr int DK = SBK ? 128 : 192, NST = DK / 16, KROW = DK * 2 + 16, KCH = DK / 8, NKI = (64 * KCH) / 512;
    asm volatile("" : "+v"(tid), "+v"(lane));
    const int ql = lane & 31, hi = lane >> 5, qw0 = q0 + 32 * wave, myq = qw0 + ql;
    const int nt = (q0 + 256) / 64;
    bf16x8 qf[NST];
    { const bf16* qrow = Qp + (size_t)myq * ldq + 8 * hi;
#pragma unroll
      for (int st = 0; st < NST; ++st) qf[st] = *(const bf16x8*)(qrow + 16 * st); }
    unsigned kgo[NKI], kls[NKI], vgo[2], vls[2];
#pragma unroll
    for (int i = 0; i < NKI; ++i) { const int c = tid + 512 * i, row = c / KCH, cc = c % KCH; kgo[i] = (unsigned)(row * ldk + cc * 8); kls[i] = (unsigned)(row * KROW + cc * 16); }
#pragma unroll
    for (int i = 0; i < 2; ++i) { const int c = tid + 512 * i, row = c >> 4, cc = c & 15; vgo[i] = (unsigned)(row * ldv + cc * 8); vls[i] = (unsigned)(row * AT_VROW + cc * 16); }
    u32x4 kr[NKI], vr[2];
#define AT_LOAD(j) do { const bf16* kp_ = Kp + (size_t)(64 * (j)) * ldk; const bf16* vp_ = Vp + (size_t)(64 * (j)) * ldv; \
        _Pragma("unroll") for (int i = 0; i < NKI; ++i) kr[i] = *(const u32x4*)(kp_ + kgo[i]); \
        _Pragma("unroll") for (int i = 0; i < 2; ++i) vr[i] = *(const u32x4*)(vp_ + vgo[i]); } while (0)
#define AT_STORE(b) do { LAS unsigned char* kb_ = lds + ((b) ? AT_K1 : AT_K0); LAS unsigned char* vb_ = lds + ((b) ? AT_V1 : AT_V0); \
        _Pragma("unroll") for (int i = 0; i < NKI; ++i) *(LAS u32x4*)(kb_ + kls[i]) = kr[i]; \
        _Pragma("unroll") for (int i = 0; i < 2; ++i) *(LAS u32x4*)(vb_ + vls[i]) = vr[i]; } while (0)
    f32x16 o[4];
#pragma unroll
    for (int d = 0; d < 4; ++d)
#pragma unroll
        for (int i = 0; i < 16; ++i) o[d][i] = 0.f;
    float m_run = -INFINITY, l_run = 0.f, carry = 0.f;
    const float qk_scale = SBK ? 0.08838834764831845f : 0.07216878364870323f;
    const float c2 = qk_scale * 1.4426950408889634f;
    const unsigned koff = (unsigned)(ql * KROW + hi * 16);
    const unsigned voff = (unsigned)((4 * hi + ((lane >> 2) & 3)) * AT_VROW + (16 * ((lane >> 4) & 1) + 4 * (lane & 3)) * 2);

    LAS unsigned* dcnt = (LAS unsigned*)(lds + AT_CNT);
    bool wdone = false;
    if (SBK && tid == 0) { dcnt[0] = 0u; dcnt[1] = 0u; dcnt[2] = 0u; }
    __syncthreads();
    { const int j0 = SBK ? nt - 1 : 0; AT_LOAD(j0); AT_STORE(0); }
    __syncthreads();
#pragma unroll 1
    for (int jj = 0; jj < nt; ++jj) {
        const int j = SBK ? nt - 1 - jj : jj, k0 = 64 * j, b = jj & 1;
        const bool more = (jj + 1 < nt);
        if (more) { const int jn = SBK ? j - 1 : j + 1; AT_LOAD(jn); }
        const bool active = SBK ? (k0 < qw0 + 31 && !wdone) : (k0 <= qw0 + 31);
        if (active) {
            const LAS unsigned char* kb = lds + (b ? AT_K1 : AT_K0) + koff;
            f32x16 s0, s1;
#pragma unroll
            for (int i = 0; i < 16; ++i) { s0[i] = 0.f; s1[i] = 0.f; }
#pragma unroll
            for (int st = 0; st < NST; ++st) {
                const bf16x8 a0 = *(const LAS bf16x8*)(kb + st * 32), a1 = *(const LAS bf16x8*)(kb + 32 * KROW + st * 32);
                s0 = __builtin_amdgcn_mfma_f32_32x32x16_bf16(a0, qf[st], s0, 0, 0, 0);
                s1 = __builtin_amdgcn_mfma_f32_32x32x16_bf16(a1, qf[st], s1, 0, 0, 0);
                if ((st & 3) == 3) __builtin_amdgcn_sched_barrier(0);
            }
            if (!SBK) {
                const bool need_mask = (k0 + 63 > qw0);
                if (need_mask) {
#pragma unroll
                    for (int i = 0; i < 16; ++i) { const int key = k0 + crow(i, hi); if (key > myq) s0[i] = -INFINITY; if (key + 32 > myq) s1[i] = -INFINITY; }
                }
                float mx = s0[0];
#pragma unroll
                for (int i = 1; i < 16; ++i) mx = fmaxf(mx, s0[i]);
#pragma unroll
                for (int i = 0; i < 16; ++i) mx = fmaxf(mx, s1[i]);
                mx = fmaxf(mx, __shfl_xor(mx, 32));
                const float m_new = fmaxf(m_run, mx);
                const float alpha = __builtin_amdgcn_exp2f((m_run - m_new) * c2);
                m_run = m_new;
                const float mc = m_new * c2;
                float ls = 0.f;
#pragma unroll
                for (int i = 0; i < 16; ++i) { s0[i] = __builtin_amdgcn_exp2f(s0[i] * c2 - mc); ls += s0[i]; }
#pragma unroll
                for (int i = 0; i < 16; ++i) { s1[i] = __builtin_amdgcn_exp2f(s1[i] * c2 - mc); ls += s1[i]; }
                l_run = l_run * alpha + ls;
#pragma unroll
                for (int d = 0; d < 4; ++d)
#pragma unroll
                    for (int i = 0; i < 16; ++i) o[d][i] *= alpha;
            } else {
                const bool need_mask = (k0 + 63 >= qw0);
                float lomv[32], own[8], par[8];
#pragma unroll
                for (int sub = 0; sub < 2; ++sub)
#pragma unroll
                    for (int i = 0; i < 16; ++i) {
                        const float z = (sub ? s1[i] : s0[i]) * qk_scale;
                        const float e = __builtin_amdgcn_exp2f(-fabsf(z) * 1.4426950408889634f);
                        float lom = -(fmaxf(z, 0.f) + __builtin_amdgcn_logf(1.0f + e) * 0.6931471805599453f);
                        float lb = z + lom;
                        if (need_mask) { const int key = k0 + 32 * sub + crow(i, hi); if (key >= myq) { lom = 0.f; lb = -INFINITY; } }
                        lomv[16 * sub + i] = lom;
                        if (sub) s1[i] = lb; else s0[i] = lb;
                    }
#pragma unroll
                for (int m = 0; m < 8; ++m) { own[m] = (lomv[4 * m] + lomv[4 * m + 1]) + (lomv[4 * m + 2] + lomv[4 * m + 3]); par[m] = __shfl_xor(own[m], 32); }
                float Tm = 0.f;
#pragma unroll
                for (int m = 7; m >= 0; --m) {
                    float run = Tm + carry + (hi == 0 ? par[m] : 0.f);
#pragma unroll
                    for (int r = 3; r >= 0; --r) {
                        const int idx = 4 * m + r;
                        const float lb = (idx >= 16) ? s1[idx - 16] : s0[idx];
                        const float a = __builtin_amdgcn_exp2f((lb + run) * 1.4426950408889634f);
                        if (idx >= 16) s1[idx - 16] = a; else s0[idx] = a;
                        run += lomv[idx];
                    }
                    Tm += own[m] + par[m];
                }
                carry += Tm;
            }
            unsigned pk[16];
#pragma unroll
            for (int js = 0; js < 2; ++js)
#pragma unroll
                for (int w = 0; w < 4; ++w) { pk[4 * js + w] = cvt_pk(s0[8 * js + 2 * w], s0[8 * js + 2 * w + 1]); pk[8 + 4 * js + w] = cvt_pk(s1[8 * js + 2 * w], s1[8 * js + 2 * w + 1]); }
            const LAS unsigned char* vb = lds + (b ? AT_V1 : AT_V0) + voff;
#pragma unroll
            for (int dt = 0; dt < 4; ++dt) {
                __builtin_amdgcn_sched_barrier(0);
#pragma unroll
                for (int ks = 0; ks < 4; ++ks) {
                    const s16x4 lo = vtr(vb + (16 * ks) * AT_VROW + dt * 64), h4 = vtr(vb + (16 * ks + 8) * AT_VROW + dt * 64);
                    const bf16x8 A = (bf16x8){lo[0], lo[1], lo[2], lo[3], h4[0], h4[1], h4[2], h4[3]};
                    const u32x4 pw = (u32x4){pk[4 * ks], pk[4 * ks + 1], pk[4 * ks + 2], pk[4 * ks + 3]};
                    o[dt] = __builtin_amdgcn_mfma_f32_32x32x16_bf16(A, __builtin_bit_cast(bf16x8, pw), o[dt], 0, 0, 0);
                }
            }
        }
        if (SBK) {
            if (!wdone && k0 < qw0 + 31) wdone = __all(carry < -104.0f);
            if (wdone && lane == 0) __hip_atomic_fetch_add(dcnt + (jj % 3), 1u, __ATOMIC_RELAXED, __HIP_MEMORY_SCOPE_WORKGROUP);
        }
        if (more) AT_STORE(b ^ 1);
        __syncthreads();
        if (SBK) {
            if (tid == 0) dcnt[(jj + 2) % 3] = 0u;
            if (dcnt[jj % 3] == 8u) break;
        }
    }
#undef AT_LOAD
#undef AT_STORE
    float inv = 1.0f;
    if (!SBK) { const float lt = l_run + __shfl_xor(l_run, 32); inv = 1.0f / lt; }
    bf16* orow = Op + (size_t)myq * ldo + 4 * hi;
#pragma unroll
    for (int dt = 0; dt < 4; ++dt)
#pragma unroll
        for (int gi = 0; gi < 4; ++gi) {
            u32x2 w; w.x = cvt_pk(o[dt][4 * gi] * inv, o[dt][4 * gi + 1] * inv); w.y = cvt_pk(o[dt][4 * gi + 2] * inv, o[dt][4 * gi + 3] * inv);
            *(u32x2*)(orow + 32 * dt + 8 * gi) = w;
        }
}

struct Args {
    const float *x, *c; const int* pos; const float *w_ada, *b_ada, *g1, *g2, *w_in, *g_ql, *g_kvl, *w_uq, *w_ukv, *g_qh, *g_kh, *w_pa, *w_pb, *w_out, *w_fi, *w_fo;
    float* out; unsigned char* ws;
};

__device__ __forceinline__ void transpose_item(const float* __restrict__ W, int K, int N, bf16* __restrict__ WT, int k0, int n0, int dest_row0, const float* __restrict__ kgain, LAS float* scr, int lane) {
#pragma unroll 8
    for (int i = 0; i < 32; ++i) { const int kk = 2 * i + (lane >> 5); float v = W[(size_t)(k0 + kk) * N + n0 + (lane & 31)]; if (kgain) v *= kgain[k0 + kk]; scr[kk * 33 + (lane & 31)] = v; }
    asm volatile("s_waitcnt lgkmcnt(0)" ::: "memory");
    const int c = lane & 7;
#pragma unroll
    for (int j = 0; j < 4; ++j) { const int n = (lane >> 3) + 8 * j; const LAS float* s = scr + (8 * c) * 33 + n;
        u32x4 o; o.x = cvt_pk(s[0 * 33], s[1 * 33]); o.y = cvt_pk(s[2 * 33], s[3 * 33]); o.z = cvt_pk(s[4 * 33], s[5 * 33]); o.w = cvt_pk(s[6 * 33], s[7 * 33]);
        *(u32x4*)(WT + (size_t)(dest_row0 + n) * K + k0 + 8 * c) = o; }
    asm volatile("s_waitcnt lgkmcnt(0)" ::: "memory");
}

__device__ __forceinline__ void p0_prologue(const Args& a, LAS unsigned char* lds, int gw, int NGW, int wave, int lane) {
    unsigned char* ws = a.ws;
    float* part = (float*)(ws + WS_KVRAW);
    for (int it = gw; it < 48 * NPART; it += NGW) {
        const int cgp = it % 48, kc = it / 48;
        float sv[4];
#pragma unroll
        for (int b = 0; b < 4; ++b) { const float cv = a.c[b * DM + kc * 64 + lane]; sv[b] = cv * fast_sigmoid(cv); }
        f32x4 acc[4];
#pragma unroll
        for (int b = 0; b < 4; ++b) acc[b] = (f32x4){0.f, 0.f, 0.f, 0.f};
        const float* wp = a.w_ada + (size_t)(kc * 64) * ADA_N + cgp * 256 + lane * 4;
#pragma unroll 8
        for (int kk = 0; kk < 64; ++kk) {
            const f32x4 w = *(const f32x4*)(wp + (size_t)kk * ADA_N);
#pragma unroll
            for (int b = 0; b < 4; ++b) { const float s = __uint_as_float(__builtin_amdgcn_readlane(__float_as_uint(sv[b]), kk)); acc[b] += w * s; }
        }
#pragma unroll
        for (int b = 0; b < 4; ++b) *(f32x4*)(part + (size_t)(kc * 4 + b) * ADA_N + cgp * 256 + lane * 4) = acc[b];
    }
    LAS float* scr = (LAS float*)(lds + wave * 8704);
    bf16* Win = (bf16*)(ws + WS_WIN); bf16* Wuq = (bf16*)(ws + WS_WUQ); bf16* Wukv = (bf16*)(ws + WS_WUKV); bf16* Wpa = (bf16*)(ws + WS_WPA); bf16* Wpb = (bf16*)(ws + WS_WPB);
    bf16* Wout = (bf16*)(ws + WS_WOUT); bf16* Wfi = (bf16*)(ws + WS_WFI); bf16* Wfo = (bf16*)(ws + WS_WFO);
    constexpr int I_IN = (DM / 64) * (DIN / 32), I_UQ = (512 / 64) * (1536 / 32), I_UKV = (512 / 64) * (2048 / 32), I_P = (1024 / 64) * (DM / 32), I_OUT = (DM / 64) * (DM / 32),
                  I_FI = (DM / 64) * (2 * DFF / 32), I_FO = (DFF / 64) * (DM / 32);
    constexpr int NITEMS = I_IN + I_UQ + I_UKV + 2 * I_P + I_OUT + I_FI + I_FO;
    for (int it = gw; it < NITEMS; it += NGW) {
        int r = it;
        if (r < I_FI) { const int nblk = 2 * DFF / 32, kb = r / nblk, nb = r % nblk; const int n0 = 32 * nb; const int jn = n0 < DFF ? n0 : n0 - DFF;
            const int dest = 256 * (jn / 128) + (jn % 128) + (n0 < DFF ? 0 : 128);
            transpose_item(a.w_fi, DM, 2 * DFF, Wfi, 64 * kb, n0, dest, nullptr, scr, lane); continue; } r -= I_FI;
        if (r < I_IN) { const int nblk = DIN / 32, kb = r / nblk, nb = r % nblk; const int n0 = 32 * nb; const int dest = n0 < 1088 ? n0 : n0 + 192;
            transpose_item(a.w_in, DM, DIN, Win, 64 * kb, n0, dest, nullptr, scr, lane); continue; } r -= I_IN;
        if (r < I_FO) { const int nblk = DM / 32, kb = r / nblk, nb = r % nblk; transpose_item(a.w_fo, DFF, DM, Wfo, 64 * kb, 32 * nb, 32 * nb, nullptr, scr, lane); continue; } r -= I_FO;
        if (r < I_OUT) { const int nblk = DM / 32, kb = r / nblk, nb = r % nblk; transpose_item(a.w_out, DM, DM, Wout, 64 * kb, 32 * nb, 32 * nb, nullptr, scr, lane); continue; } r -= I_OUT;
        if (r < I_P) { const int nblk = DM / 32, kb = r / nblk, nb = r % nblk; transpose_item(a.w_pa, 1024, DM, Wpa, 64 * kb, 32 * nb, 32 * nb, nullptr, scr, lane); continue; } r -= I_P;
        if (r < I_P) { const int nblk = DM / 32, kb = r / nblk, nb = r % nblk; transpose_item(a.w_pb, 1024, DM, Wpb, 64 * kb, 32 * nb, 32 * nb, nullptr, scr, lane); continue; } r -= I_P;
        if (r < I_UQ) { const int nblk = 1536 / 32, kb = r / nblk, nb = r % nblk; transpose_item(a.w_uq, 512, 1536, Wuq, 64 * kb, 32 * nb, 32 * nb, a.g_ql, scr, lane); continue; } r -= I_UQ;
        { const int nblk = 2048 / 32, kb = r / nblk, nb = r % nblk; transpose_item(a.w_ukv, 512, 2048, Wukv, 64 * kb, 32 * nb, 32 * nb, a.g_kvl, scr, lane); }
    }
    for (int p = gw * 64 + lane; p < 192 * DM / 8; p += NGW * 64) *(u32x4*)(Win + (size_t)1088 * DM + (size_t)p * 8) = (u32x4){0u, 0u, 0u, 0u};
}

__device__ __forceinline__ void norm_rows(const float* __restrict__ src, bf16* __restrict__ dst, const LAS float* scale, const LAS float* shift, int row0, int wave, int lane) {
#pragma unroll 1
    for (int r = 0; r < 8; ++r) {
        const int row = row0 + wave * 8 + r;
        const f32x4* xr = (const f32x4*)(src + (size_t)row * DM) + lane;
        f32x4 v[8]; float ss = 0.f;
#pragma unroll
        for (int j = 0; j < 8; ++j) { v[j] = xr[64 * j]; ss += (v[j].x * v[j].x + v[j].y * v[j].y) + (v[j].z * v[j].z + v[j].w * v[j].w); }
        const float rstd = 1.0f / sqrtf(wave_sum(ss) * (1.0f / DM) + EPS);
        u32x2* orow = (u32x2*)(dst + (size_t)row * DM) + lane;
#pragma unroll
        for (int j = 0; j < 8; ++j) { const int col = 4 * (64 * j + lane); const f32x4 sc = *(const LAS f32x4*)(scale + col), sh = *(const LAS f32x4*)(shift + col);
            const f32x4 y = v[j] * rstd * sc + sh; u32x2 w; w.x = cvt_pk(y.x, y.y); w.y = cvt_pk(y.z, y.w); orow[64 * j] = w; }
    }
}

#define XB_TMO      128
#define XB_XCNT(j)  (256  + 64 * (j))
#define XB_XSUB(j)  (1280 + 64 * (j))
#define XB_XGEN(j)  (2304 + 64 * (j))
#define XB_TOP      3328
#define XB_TOPGEN   3392
#define XCD_BAR_WORDS 3456
#define XB_SPIN_CAP (1u << 20)
__device__ __forceinline__ unsigned xb_ld(unsigned* p)              { return __hip_atomic_load(p, __ATOMIC_RELAXED, __HIP_MEMORY_SCOPE_AGENT); }
__device__ __forceinline__ unsigned xb_add(unsigned* p, unsigned v) { return __hip_atomic_fetch_add(p, v, __ATOMIC_RELAXED, __HIP_MEMORY_SCOPE_AGENT); }
__device__ __forceinline__ unsigned xb_xcc_id() { return (unsigned)__builtin_amdgcn_s_getreg((3 << 11) | 20) & 0xFu; }
#define XB_SPIN(cond, bar) do { unsigned _sp = 0; while (cond) { __builtin_amdgcn_s_sleep(1); \
    if ((++_sp & 255u) == 0u) { if (xb_ld(&(bar)[XB_TMO])) break; if (_sp > XB_SPIN_CAP) { atomicAdd(&(bar)[XB_TMO], 1u); break; } } } } while (0)
struct XcdBarrier { unsigned* bar; unsigned x; volatile LAS unsigned* st; };
__device__ __forceinline__ XcdBarrier xcd_barrier_post(unsigned* bar, volatile LAS unsigned* st) {
    XcdBarrier b; b.bar = bar; b.x = xb_xcc_id(); b.st = st;
    if (threadIdx.x == 0) (void)xb_add(&bar[XB_XCNT(b.x)], 1u);
    return b;
}
__device__ __forceinline__ void xcd_barrier_complete(unsigned* bar, unsigned x, unsigned& nloc, unsigned& nx) {
    const unsigned G = gridDim.x * gridDim.y * gridDim.z;
    unsigned sum, cnt, mine, sp = 0u;
    for (;;) {
        sum = 0u; cnt = 0u; mine = 0u;
#pragma unroll
        for (unsigned j = 0; j < 16; ++j) { const unsigned c = xb_ld(&bar[XB_XCNT(j)]); sum += c; cnt += (c > 0u) ? 1u : 0u; mine = (j == x) ? c : mine; }
        if (sum == G) break;
        __builtin_amdgcn_s_sleep(1);
        if ((++sp & 255u) == 0u) { if (xb_ld(&bar[XB_TMO])) break; if (sp > XB_SPIN_CAP) { atomicAdd(&bar[XB_TMO], 1u); break; } }
    }
    nloc = mine > 0u ? mine : 1u; nx = cnt > 0u ? cnt : 1u;
}
__device__ __forceinline__ void xcd_barrier(const XcdBarrier& b) {
    asm volatile("s_waitcnt vmcnt(0)" ::: "memory");
    __syncthreads();
    if (threadIdx.x == 0) {
        unsigned* bar = b.bar;
        __builtin_amdgcn_s_waitcnt(0);
        unsigned nloc = b.st[0], nx = b.st[1];
        if (nloc == 0u) { xcd_barrier_complete(bar, b.x, nloc, nx); b.st[0] = nloc; b.st[1] = nx; }
        const unsigned old = xb_add(&bar[XB_XSUB(b.x)], 1u);
        const unsigned gen = old / nloc;
        if (old + 1u == (gen + 1u) * nloc) {
            __builtin_amdgcn_fence(__ATOMIC_RELEASE, "agent");
            asm volatile("s_waitcnt vmcnt(0)" ::: "memory");
            const unsigned og = xb_add(&bar[XB_TOP], 1u);
            const unsigned tg = og / nx;
            if (og + 1u == (tg + 1u) * nx) xb_add(&bar[XB_TOPGEN], 1u);
            else XB_SPIN(xb_ld(&bar[XB_TOPGEN]) == tg, bar);
            __builtin_amdgcn_fence(__ATOMIC_ACQUIRE, "agent");
            xb_add(&bar[XB_XGEN(b.x)], 1u);
            asm volatile("s_waitcnt vmcnt(0)" ::: "memory");
        } else {
            XB_SPIN(xb_ld(&bar[XB_XGEN(b.x)]) == gen, bar);
            __builtin_amdgcn_fence(__ATOMIC_ACQUIRE, "agent");
            asm volatile("s_waitcnt vmcnt(0)" ::: "memory");
        }
    }
    __syncthreads();
}

__global__ void __launch_bounds__(512, 2) fwd_megakernel(Args a) {
    extern __shared__ __attribute__((aligned(16))) unsigned char lds_raw[];
    LAS unsigned char* lds = (LAS unsigned char*)lds_raw;
    cg::grid_group grid = cg::this_grid();
    const int tid = threadIdx.x, lane = tid & 63, wave = __builtin_amdgcn_readfirstlane(tid >> 6);
    const int G = gridDim.x, bx = blockIdx.x;
    const int vcu = (G % 8 == 0) ? (bx % 8) * (G / 8) + bx / 8 : bx;
    const int gw = vcu * 8 + wave, NGW = G * 8;
    unsigned char* ws = a.ws;
    float* ada = (float*)(ws + WS_ADA);
    float* part = (float*)(ws + WS_KVRAW);
    bf16* Win = (bf16*)(ws + WS_WIN); bf16* Wuq = (bf16*)(ws + WS_WUQ); bf16* Wukv = (bf16*)(ws + WS_WUKV); bf16* Wpa = (bf16*)(ws + WS_WPA); bf16* Wpb = (bf16*)(ws + WS_WPB);
    bf16* Wout = (bf16*)(ws + WS_WOUT); bf16* Wfi = (bf16*)(ws + WS_WFI); bf16* Wfo = (bf16*)(ws + WS_WFO);
    bf16* proj = (bf16*)(ws + WS_PROJ); bf16* act = (bf16*)(ws + WS_PROJ);
    bf16* kvraw = (bf16*)(ws + WS_KVRAW); bf16* merged = (bf16*)(ws + WS_KVRAW);
    bf16* ybuf = (bf16*)(ws + WS_Y); bf16* h2 = (bf16*)(ws + WS_Y);
    bf16* hbuf = (bf16*)a.out; bf16* qbuf = (bf16*)a.out; bf16* kbuf = (bf16*)((unsigned char*)a.out + DO_K);
    LAS float* tscale = (LAS float*)lds; LAS float* tshift = (LAS float*)(lds + 8192);
    volatile LAS unsigned* bst = (volatile LAS unsigned*)(lds + LDS_MISC);
    if (tid == 0) { bst[0] = 0u; bst[1] = 0u; }
    __syncthreads();
    const XcdBarrier xbar = xcd_barrier_post((unsigned*)(ws + WS_BAR), bst);
#define GRID_BAR() xcd_barrier(xbar)

    p0_prologue(a, lds, gw, NGW, wave, lane);
    grid.sync();

    for (int e = bx * 512 + tid; e < NB * ADA_N; e += G * 512) { const int b = e / ADA_N, n = e % ADA_N; float v = a.b_ada[n];
        for (int p = 0; p < NPART; ++p) v += part[(size_t)(p * 4 + b) * ADA_N + n];
        ada[e] = v; }
    for (int ch = bx; ch < T / 64; ch += G) {
        const int b = (ch * 64) / SEQ;
        __syncthreads();
        for (int d = tid; d < DM; d += 512) { float sh = a.b_ada[d], sc = a.b_ada[DM + d];
            for (int p = 0; p < NPART; ++p) { sh += part[(size_t)(p * 4 + b) * ADA_N + d]; sc += part[(size_t)(p * 4 + b) * ADA_N + DM + d]; }
            tscale[d] = a.g1[d] * (1.0f + sc); tshift[d] = sh; }
        __syncthreads();
        norm_rows(a.x, hbuf, tscale, tshift, ch * 64, wave, lane);
    }
    GRID_BAR();

    { pg8::Gemm g{hbuf, Win, T, PLD, DM, DM, DM}; pg8::StaticOrder S; S.init(T, PLD, G, bx); pg8::EpiBf16 E{proj, PLD}; pg8::gemm_phase(lds, g, S, E); }
    GRID_BAR();

    { pg8::Gemm g{proj, Wuq, T, 1536, 512, PLD, 512}; pg8::StaticOrder S; S.init(T, 1536, G, bx); pg8::EpiBf16 E{qbuf, 1536}; pg8::gemm_phase(lds, g, S, E); }
    { pg8::Gemm g{proj + 512, Wukv, T, 2048, 512, PLD, 512}; pg8::StaticOrder S; S.init(T, 2048, G, bx); pg8::EpiBf16 E{kvraw, 2048}; pg8::gemm_phase(lds, g, S, E); }
    GRID_BAR();

    for (int t = gw; t < T; t += NGW) {
        const bf16* prow = proj + (size_t)t * PLD;
        float aq, akv;
        { const u32x4 u = *(const u32x4*)(prow + lane * 8); float s = bf_lo(u.x) * bf_lo(u.x) + bf_hi(u.x) * bf_hi(u.x) + bf_lo(u.y) * bf_lo(u.y) + bf_hi(u.y) * bf_hi(u.y)
              + bf_lo(u.z) * bf_lo(u.z) + bf_hi(u.z) * bf_hi(u.z) + bf_lo(u.w) * bf_lo(u.w) + bf_hi(u.w) * bf_hi(u.w);
          aq = 1.0f / sqrtf(wave_sum(s) * (1.0f / 512.0f) + EPS); }
        { const u32x4 u = *(const u32x4*)(prow + 512 + lane * 8); float s = bf_lo(u.x) * bf_lo(u.x) + bf_hi(u.x) * bf_hi(u.x) + bf_lo(u.y) * bf_lo(u.y) + bf_hi(u.y) * bf_hi(u.y)
              + bf_lo(u.z) * bf_lo(u.z) + bf_hi(u.z) * bf_hi(u.z) + bf_lo(u.w) * bf_lo(u.w) + bf_hi(u.w) * bf_hi(u.w);
          akv = 1.0f / sqrtf(wave_sum(s) * (1.0f / 512.0f) + EPS); }
        const float kpe = bf2f(prow[C_KPE + lane]);
        const float ang = (float)a.pos[t] * ROPE_FREQ[lane & 31];
        double rev = (double)ang * 0.15915494309189535; rev -= __builtin_rint(rev);
        const float sn = __builtin_amdgcn_sinf((float)rev), cs = __builtin_amdgcn_cosf((float)rev);
        const float gq0 = a.g_qh[lane], gq1 = a.g_qh[64 + lane], gq2 = a.g_qh[128 + lane];
        const float gk0 = a.g_kh[lane], gk1 = a.g_kh[64 + lane], gk2 = a.g_kh[128 + lane];
        bf16* qrow = qbuf + (size_t)t * 1536; bf16* krow = kbuf + (size_t)t * 1536; bf16* kvrow = kvraw + (size_t)t * 2048;
#pragma unroll 2
        for (int h = 0; h < NH; ++h) {
            { bf16* qh = qrow + h * DQK;
              const float e0 = bf2f(qh[lane]) * aq, e1 = bf2f(qh[64 + lane]) * aq, e2 = bf2f(qh[128 + lane]) * aq;
              const float rstd = 1.0f / sqrtf(wave_sum(e0 * e0 + e1 * e1 + e2 * e2) * (1.0f / DQK) + EPS);
              const float f2 = e2 * rstd * gq2, pf = __shfl_xor(f2, 32);
              const float rot = lane < 32 ? f2 * cs - pf * sn : pf * sn + f2 * cs;
              qh[lane] = f2bf(e0 * rstd * gq0); qh[64 + lane] = f2bf(e1 * rstd * gq1); qh[128 + lane] = f2bf(rot); }
            { const bf16* kn = kvrow + h * 256; bf16* kh = krow + h * DQK;
              const float e0 = bf2f(kn[lane]) * akv, e1 = bf2f(kn[64 + lane]) * akv, e2 = kpe;
              const float rstd = 1.0f / sqrtf(wave_sum(e0 * e0 + e1 * e1 + e2 * e2) * (1.0f / DQK) + EPS);
              const float f2 = e2 * rstd * gk2, pf = __shfl_xor(f2, 32);
              const float rot = lane < 32 ? f2 * cs - pf * sn : pf * sn + f2 * cs;
              kh[lane] = f2bf(e0 * rstd * gk0); kh[64 + lane] = f2bf(e1 * rstd * gk1); kh[128 + lane] = f2bf(rot); }
            { unsigned* vp = (unsigned*)(kvrow + h * 256 + 128) + lane; const unsigned u = *vp; *vp = cvt_pk(bf_lo(u) * akv, bf_hi(u) * akv); }
        }
    }
    GRID_BAR();

    for (int su = vcu; su < 256; su += G) {
        const int bh = su >> 3, p = su & 7, b = bh >> 3, h = bh & 7;
        const size_t r0 = (size_t)b * SEQ;
#pragma unroll 1
        for (int half = 0; half < 2; ++half) {
            const int qb = half ? 15 - p : p;
            attn_unit<false>(lds, qbuf + r0 * 1536 + h * DQK, 1536, kbuf + r0 * 1536 + h * DQK, 1536, kvraw + r0 * 2048 + h * 256 + 128, 2048, ybuf + r0 * DM + h * 128, DM, qb * 256, tid, wave, lane);
            attn_unit<true>(lds, proj + r0 * PLD + C_SBQ + h * 128, PLD, proj + r0 * PLD + C_SBK + h * 128, PLD, proj + r0 * PLD + C_SBV + h * 128, PLD, ybuf + r0 * DM + 1024 + h * 128, DM, qb * 256, tid, wave, lane);
        }
    }
    GRID_BAR();

    { pg8::Gemm g{ybuf, Wpa, T, DM, 1024, DM, 1024}; pg8::StaticOrder S; S.init(T, DM, G, bx); pg8::EpiGate<false> E{merged, DM, proj + C_GA, PLD}; pg8::gemm_phase(lds, g, S, E); }
    { pg8::Gemm g{ybuf + 1024, Wpb, T, DM, 1024, DM, 1024}; pg8::StaticOrder S; S.init(T, DM, G, bx); pg8::EpiGate<true> E{merged, DM, proj + C_GB, PLD}; pg8::gemm_phase(lds, g, S, E); }
    GRID_BAR();

    { pg8::Gemm g{merged, Wout, T, DM, DM, DM, DM}; pg8::StaticOrder S; S.init(T, DM, G, bx); pg8::EpiRes E{a.x, a.out, ada + 2 * DM, ADA_N}; pg8::gemm_phase(lds, g, S, E); }
    GRID_BAR();

    for (int ch = bx; ch < T / 64; ch += G) {
        const int b = (ch * 64) / SEQ;
        __syncthreads();
        for (int d = tid; d < DM; d += 512) { tscale[d] = a.g2[d] * (1.0f + ada[b * ADA_N + 4 * DM + d]); tshift[d] = ada[b * ADA_N + 3 * DM + d]; }
        __syncthreads();
        norm_rows(a.out, h2, tscale, tshift, ch * 64, wave, lane);
    }
    GRID_BAR();

    { pg8::Gemm g{h2, Wfi, T, 2 * DFF, DM, DM, DM}; pg8::StaticOrder S; S.init(T, 2 * DFF, G, bx); pg8::EpiSwiglu E{act, DFF}; pg8::gemm_phase(lds, g, S, E); }
    GRID_BAR();

    { pg8::Gemm g{act, Wfo, T, DM, DFF, DFF, DFF}; pg8::StaticOrder S; S.init(T, DM, G, bx); pg8::EpiRes E{a.out, a.out, ada + 5 * DM, ADA_N}; pg8::gemm_phase(lds, g, S, E); }
}

constexpr int LDS_BYTES = 147456;
extern "C" void kernel_launch(void* const* d_in, const int* in_sizes, int n_in, void* d_out, int out_size, void* d_ws, size_t ws_size, hipStream_t stream) {
    static int grid = 0;
    if (grid == 0) {
        if (n_in != 19 || out_size != T * DM || ws_size < WS_END) { fprintf(stderr, "kernel_launch: unexpected problem (n_in %d out %d ws %zu)\n", n_in, out_size, ws_size); grid = -1; return; }
        int dev = 0, cus = 0, per_cu = 0;
        hipGetDevice(&dev); hipDeviceGetAttribute(&cus, hipDeviceAttributeMultiprocessorCount, dev);
        if (hipFuncSetAttribute((const void*)fwd_megakernel, hipFuncAttributeMaxDynamicSharedMemorySize, LDS_BYTES) != hipSuccess) { fprintf(stderr, "kernel_launch: hipFuncSetAttribute failed\n"); grid = -1; return; }
        if (hipOccupancyMaxActiveBlocksPerMultiprocessor(&per_cu, (const void*)fwd_megakernel, 512, LDS_BYTES) != hipSuccess || per_cu < 1) { fprintf(stderr, "kernel_launch: occupancy query failed (%d)\n", per_cu); per_cu = 1; }
        (void)hipGetLastError();
        grid = cus * (per_cu > 1 ? 1 : per_cu);
    }
    if (grid < 0) return;
    Args a{};
    a.x = (const float*)d_in[0]; a.c = (const float*)d_in[1]; a.pos = (const int*)d_in[2]; a.w_ada = (const float*)d_in[3]; a.b_ada = (const float*)d_in[4];
    a.g1 = (const float*)d_in[5]; a.g2 = (const float*)d_in[6]; a.w_in = (const float*)d_in[7]; a.g_ql = (const float*)d_in[8]; a.g_kvl = (const float*)d_in[9];
    a.w_uq = (const float*)d_in[10]; a.w_ukv = (const float*)d_in[11]; a.g_qh = (const float*)d_in[12]; a.g_kh = (const float*)d_in[13]; a.w_pa = (const float*)d_in[14];
    a.w_pb = (const float*)d_in[15]; a.w_out = (const float*)d_in[16]; a.w_fi = (const float*)d_in[17]; a.w_fo = (const float*)d_in[18];
    a.out = (float*)d_out; a.ws = (unsigned char*)d_ws;
    if (hipMemsetAsync((char*)d_ws + WS_BAR, 0, 16384, stream) != hipSuccess) { fprintf(stderr, "kernel_launch: memset failed\n"); return; }
    void* args[] = {&a};
    hipError_t e = hipLaunchCooperativeKernel((const void*)fwd_megakernel, dim3(grid), dim3(512), args, LDS_BYTES, stream);
    if (e != hipSuccess) fprintf(stderr, "kernel_launch: cooperative launch failed: %s (grid %d)\n", hipGetErrorString(e), grid);
}
```

```cpp
#include <hip/hip_runtime.h>
#include <hip/hip_cooperative_groups.h>
#include <cstdio>
#include <cstdint>
namespace cg = cooperative_groups;

#define LAS __attribute__((address_space(3)))
typedef unsigned short bf16;
typedef short bf16x8 __attribute__((ext_vector_type(8)));
typedef short s16x4 __attribute__((ext_vector_type(4)));
typedef float f32x2 __attribute__((ext_vector_type(2)));
typedef float f32x4 __attribute__((ext_vector_type(4)));
typedef float f32x16 __attribute__((ext_vector_type(16)));
typedef unsigned u32x4 __attribute__((ext_vector_type(4)));
typedef unsigned u32x2 __attribute__((ext_vector_type(2)));
typedef __bf16 bf16x2_t __attribute__((ext_vector_type(2)));

constexpr int NB = 4, SEQ = 4096, T = NB * SEQ, DM = 2048;
constexpr int NH = 8, DQK = 192, DFF = 5632, DIN = 8256, PLD = 8448;
constexpr int C_KPE = 1024, C_SBQ = 1280, C_SBK = 2304, C_SBV = 3328, C_GA = 4352, C_GB = 6400;
constexpr int ADA_N = 6 * DM;
constexpr int NPART = 32;
constexpr float EPS = 1e-6f;
constexpr size_t MiB = 1u << 20;
constexpr int LDS_MISC = 131072 + 512;
constexpr size_t WS_ADA = 0;
constexpr size_t WS_WIN = 1 * MiB, WS_WUQ = 34 * MiB, WS_WUKV = 36 * MiB, WS_WPA = 38 * MiB, WS_WPB = 42 * MiB, WS_WOUT = 46 * MiB, WS_WFI = 54 * MiB, WS_WFO = 98 * MiB;
constexpr size_t WS_PROJ = 120 * MiB;
constexpr size_t WS_KVRAW = 384 * MiB;
constexpr size_t WS_Y = 448 * MiB;
constexpr size_t WS_END = 512 * MiB;
constexpr size_t DO_Q = 64 * MiB;

__device__ unsigned g_ctl[8192];
__device__ const float ROPE_FREQ[32] = {1.0f, 0.7498942613601685f, 0.5623413324356079f, 0.4216965138912201f, 0.3162277638912201f, 0.23713737726211548f, 0.17782793939113617f, 0.133352130651474f,
    0.10000000149011612f, 0.07498941570520401f, 0.05623413249850273f, 0.04216965287923813f, 0.03162277489900589f, 0.023713737726211548f, 0.017782794311642647f, 0.01333521492779255f,
    0.009999999776482582f, 0.007498941849917173f, 0.005623413249850273f, 0.0042169648222625256f, 0.003162277629598975f, 0.00237137358635664f, 0.0017782794311642647f, 0.0013335214462131262f,
    0.0010000000474974513f, 0.0007498942431993783f, 0.000562341301701963f, 0.0004216965171508491f, 0.0003162277571391314f, 0.00023713737027719617f, 0.00017782794020604342f, 0.0001333521504420787f};

__device__ __forceinline__ unsigned cvt_pk(float lo, float hi) { f32x2 v = {lo, hi}; bf16x2_t b = __builtin_convertvector(v, bf16x2_t); return __builtin_bit_cast(unsigned, b); }
__device__ __forceinline__ float bf_lo(unsigned u) { return __uint_as_float(u << 16); }
__device__ __forceinline__ float bf_hi(unsigned u) { return __uint_as_float(u & 0xffff0000u); }
__device__ __forceinline__ float bf2f(bf16 b) { return __uint_as_float((unsigned)b << 16); }
__device__ __forceinline__ bf16 f2bf(float f) { return (bf16)(cvt_pk(f, 0.f) & 0xffffu); }
__device__ __forceinline__ float wave_sum(float v) {
#pragma unroll
    for (int o = 1; o < 64; o <<= 1) v += __shfl_xor(v, o);
    return v;
}
__device__ __forceinline__ float fast_sigmoid(float x) { return __builtin_amdgcn_rcpf(1.0f + __expf(-x)); }

namespace pg8 {
constexpr int BM = 256, BK = 64, HALF = 128, HTB = HALF * BK * 2, STAGE_BYTES = 8 * HTB, NXCD = 8, WGM = 8;
__host__ __device__ __forceinline__ int lds_byte(int r, int c) { const int st = (r >> 4) * 2 + (c >> 5), rr = r & 15, cc = c & 31, ob = rr * 64 + cc * 2; return st * 1024 + (ob ^ (((ob >> 9) & 1) << 5)); }
__host__ __device__ __forceinline__ void stage_rc(int b, int& R, int& C) { const int st = b / 1024, sb = b % 1024, swz = sb ^ (((sb >> 9) & 1) << 5); R = (st >> 1) * 16 + swz / 64; C = (st & 1) * 32 + (swz % 64) / 2; }
__host__ __device__ __forceinline__ int perm32(int rho) { const int n = rho >> 4, i = rho & 15; return 8 * (i >> 2) + 4 * n + (i & 3); }
struct Unit { int pm, pn; };
struct Gemm { const bf16* A; const bf16* Bt; int M, N, K, lda, ldb; };
struct StaticOrder {
    int nM, nN, nwg, G, c;
    __device__ void init(int M, int N, int G_, int c_) { nM = M / BM; nN = N / BM; nwg = nM * nN; G = G_; c = c_; }
    __device__ bool next(int i, Unit& u) const {
        const long L = (long)i * G + c; if (L >= nwg) return false;
        int wgid = (int)L; { const int q = nwg / NXCD, r = nwg % NXCD, xcd = wgid % NXCD, off = wgid / NXCD; wgid = (xcd < r ? xcd * (q + 1) : r * (q + 1) + (xcd - r) * q) + off; }
        const int nig = WGM * nN, gid = wgid / nig, fm = gid * WGM, gsz = (nM - fm) < WGM ? (nM - fm) : WGM;
        u.pm = fm + ((wgid % nig) % gsz); u.pn = (wgid % nig) / gsz; return true;
    }
};
typedef f32x4 Acc[2][2][4][2];

struct EpiBf16 {
    bf16* O; int ldc;
    __device__ __forceinline__ void operator()(const Acc& acc, const Unit& u, int wr, int wc, int fr, int fq) const {
        const int row0 = u.pm * BM + wr * 64 + fr, col0 = u.pn * BM + wc * 32 + 8 * fq;
#pragma unroll
        for (int ai = 0; ai < 2; ++ai)
#pragma unroll
            for (int m = 0; m < 4; ++m) { bf16* rowp = O + (size_t)(row0 + ai * HALF + m * 16) * ldc + col0;
#pragma unroll
                for (int bj = 0; bj < 2; ++bj) { const f32x4 v0 = acc[ai][bj][m][0], v1 = acc[ai][bj][m][1];
                    u32x4 w; w.x = cvt_pk(v0[0], v0[1]); w.y = cvt_pk(v0[2], v0[3]); w.z = cvt_pk(v1[0], v1[1]); w.w = cvt_pk(v1[2], v1[3]);
                    *(u32x4*)(rowp + bj * HALF) = w; } }
    }
};
template <bool ACCUM> struct EpiGate {
    bf16* O; int ldc; const bf16* gate; int ldg;
    __device__ __forceinline__ void operator()(const Acc& acc, const Unit& u, int wr, int wc, int fr, int fq) const {
        const int row0 = u.pm * BM + wr * 64 + fr, col0 = u.pn * BM + wc * 32 + 8 * fq;
#pragma unroll
        for (int ai = 0; ai < 2; ++ai)
#pragma unroll
            for (int m = 0; m < 4; ++m) { const size_t row = (size_t)(row0 + ai * HALF + m * 16);
#pragma unroll
                for (int bj = 0; bj < 2; ++bj) {
                    const u32x4 g = *(const u32x4*)(gate + row * ldg + col0 + bj * HALF);
                    const f32x4 v0 = acc[ai][bj][m][0], v1 = acc[ai][bj][m][1];
                    float r[8];
                    r[0] = v0[0] * fast_sigmoid(bf_lo(g.x)); r[1] = v0[1] * fast_sigmoid(bf_hi(g.x)); r[2] = v0[2] * fast_sigmoid(bf_lo(g.y)); r[3] = v0[3] * fast_sigmoid(bf_hi(g.y));
                    r[4] = v1[0] * fast_sigmoid(bf_lo(g.z)); r[5] = v1[1] * fast_sigmoid(bf_hi(g.z)); r[6] = v1[2] * fast_sigmoid(bf_lo(g.w)); r[7] = v1[3] * fast_sigmoid(bf_hi(g.w));
                    bf16* op = O + row * ldc + col0 + bj * HALF;
                    if (ACCUM) { const u32x4 o = *(const u32x4*)op;
                        r[0] += bf_lo(o.x); r[1] += bf_hi(o.x); r[2] += bf_lo(o.y); r[3] += bf_hi(o.y); r[4] += bf_lo(o.z); r[5] += bf_hi(o.z); r[6] += bf_lo(o.w); r[7] += bf_hi(o.w); }
                    u32x4 w; w.x = cvt_pk(r[0], r[1]); w.y = cvt_pk(r[2], r[3]); w.z = cvt_pk(r[4], r[5]); w.w = cvt_pk(r[6], r[7]);
                    *(u32x4*)op = w; } }
    }
};
struct EpiRes {
    const float* base; float* out; const float* gt; int gt_ld;
    __device__ __forceinline__ void operator()(const Acc& acc, const Unit& u, int wr, int wc, int fr, int fq) const {
        const int row0 = u.pm * BM + wr * 64 + fr, col0 = u.pn * BM + wc * 32 + 8 * fq;
        const float* gp = gt + (size_t)((u.pm * BM) / SEQ) * gt_ld + col0;
        f32x4 gv[2][2];
#pragma unroll
        for (int bj = 0; bj < 2; ++bj)
#pragma unroll
            for (int n = 0; n < 2; ++n) gv[bj][n] = *(const f32x4*)(gp + bj * HALF + 4 * n);
#pragma unroll
        for (int ai = 0; ai < 2; ++ai)
#pragma unroll
            for (int m = 0; m < 4; ++m) { const size_t off = (size_t)(row0 + ai * HALF + m * 16) * DM + col0;
#pragma unroll
                for (int bj = 0; bj < 2; ++bj)
#pragma unroll
                    for (int n = 0; n < 2; ++n) { const f32x4 b = *(const f32x4*)(base + off + bj * HALF + 4 * n);
                        *(f32x4*)(out + off + bj * HALF + 4 * n) = b + gv[bj][n] * acc[ai][bj][m][n]; } }
    }
};
struct EpiSwiglu {
    bf16* O; int ldc;
    __device__ __forceinline__ void operator()(const Acc& acc, const Unit& u, int wr, int wc, int fr, int fq) const {
        const int row0 = u.pm * BM + wr * 64 + fr, col0 = u.pn * HALF + wc * 32 + 8 * fq;
#pragma unroll
        for (int ai = 0; ai < 2; ++ai)
#pragma unroll
            for (int m = 0; m < 4; ++m) { float r[8];
#pragma unroll
                for (int n = 0; n < 2; ++n)
#pragma unroll
                    for (int e = 0; e < 4; ++e) { const float g = acc[ai][0][m][n][e], up = acc[ai][1][m][n][e]; r[4 * n + e] = g * fast_sigmoid(g) * up; }
                u32x4 w; w.x = cvt_pk(r[0], r[1]); w.y = cvt_pk(r[2], r[3]); w.z = cvt_pk(r[4], r[5]); w.w = cvt_pk(r[6], r[7]);
                *(u32x4*)(O + (size_t)(row0 + ai * HALF + m * 16) * ldc + col0) = w; }
    }
};

template <class Epi>
__device__ __forceinline__ void gemm_phase(LAS unsigned char* lds, const Gemm g, const StaticOrder& S, const Epi& E) {
    int tid = threadIdx.x;
    asm volatile("" : "+v"(tid));
    const int wid = __builtin_amdgcn_readfirstlane(tid >> 6), lane = tid & 63, wr = wid >> 2, wc = wid & 3, fr = lane & 15, fq = lane >> 4;
    const int K = g.K, nt = K / BK;
    unsigned voffA[2], voffB[2];
#pragma unroll
    for (int i = 0; i < 2; ++i) { int R, C; stage_rc(tid * 16 + i * 8192, R, C); const int Rb = (R & ~31) + perm32(R & 31);
        voffA[i] = (unsigned)(R * g.lda + C) * 2u; voffB[i] = (unsigned)(Rb * g.ldb + C) * 2u; }
    const size_t kstep = (size_t)(BK * 2);
    const size_t hstepA = (size_t)HALF * g.lda * 2, hstepB = (size_t)HALF * g.ldb * 2;
    const size_t tstepA = 2 * hstepA, tstepB = 2 * hstepB;
    const unsigned ldsw = (unsigned)wid * 1024u;
    const int aoff = lds_byte(wr * 64 + fr, fq * 8), boff = lds_byte(wc * 32 + fr, fq * 8);
#define PG8_SA(b, h) (((b) * 2 + (h)) * HTB)
#define PG8_SB(b, h) ((4 + (b) * 2 + (h)) * HTB)
#define PG8_STAGE(bufoff, gbase, voff) do { _Pragma("unroll") for (int _i = 0; _i < 2; ++_i) \
        __builtin_amdgcn_global_load_lds((const unsigned*)((const char*)(gbase) + (voff)[_i]), (LAS unsigned*)(lds + (bufoff) + ldsw + _i * 8192), 16, 0, 0); } while (0)
#define PG8_LDA(dst, b, h) do { _Pragma("unroll") for (int m = 0; m < 4; ++m) _Pragma("unroll") for (int k = 0; k < 2; ++k) dst[m][k] = *(const LAS bf16x8*)(lds + PG8_SA(b, h) + aoff + m * 2048 + k * 1024); } while (0)
#define PG8_LDB(dst, b, h) do { _Pragma("unroll") for (int n = 0; n < 2; ++n) _Pragma("unroll") for (int k = 0; k < 2; ++k) dst[n][k] = *(const LAS bf16x8*)(lds + PG8_SB(b, h) + boff + n * 2048 + k * 1024); } while (0)
#define PG8_MMA(ai, bj, At, Bt) do { __builtin_amdgcn_s_setprio(1); _Pragma("unroll") for (int m = 0; m < 4; ++m) _Pragma("unroll") for (int n = 0; n < 2; ++n) _Pragma("unroll") for (int k = 0; k < 2; ++k) \
        acc[ai][bj][m][n] = __builtin_amdgcn_mfma_f32_16x16x32_bf16(Bt[n][k], At[m][k], acc[ai][bj][m][n], 0, 0, 0); __builtin_amdgcn_s_setprio(0); } while (0)
#define PG8_WAIT_V(n) asm volatile("s_waitcnt vmcnt(" #n ")" ::: "memory")
#define PG8_WAIT_L(n) asm volatile("s_waitcnt lgkmcnt(" #n ")" ::: "memory")
#define PG8_BAR __builtin_amdgcn_s_barrier()
#define PG8_SCHED __builtin_amdgcn_sched_barrier(0)
    Unit cur, nxt; int ui = 0;
    if (!S.next(0, cur)) return;
    Acc acc;
#pragma unroll
    for (int a = 0; a < 2; ++a)
#pragma unroll
        for (int b = 0; b < 2; ++b)
#pragma unroll
            for (int m = 0; m < 4; ++m)
#pragma unroll
                for (int n = 0; n < 2; ++n) acc[a][b][m][n] = (f32x4){0.f, 0.f, 0.f, 0.f};
    bf16x8 At[4][2], B0[2][2], B1[2][2];
    const char* cA = (const char*)g.A + (size_t)cur.pm * tstepA; const char* cB = (const char*)g.Bt + (size_t)cur.pn * tstepB;
    PG8_STAGE(PG8_SB(0, 0), cB, voffB); PG8_STAGE(PG8_SB(0, 1), cB + hstepB, voffB); PG8_STAGE(PG8_SA(0, 0), cA, voffA); PG8_STAGE(PG8_SA(0, 1), cA + hstepA, voffA);
    if (wr == 1) PG8_BAR;
    PG8_WAIT_V(2); PG8_BAR;
    PG8_STAGE(PG8_SB(1, 0), cB + kstep, voffB); PG8_STAGE(PG8_SA(1, 0), cA + kstep, voffA); PG8_STAGE(PG8_SB(1, 1), cB + hstepB + kstep, voffB);
    PG8_WAIT_V(6); PG8_BAR;
    for (;;) {
        const bool has_next = S.next(ui + 1, nxt);
        const char* nA = has_next ? (const char*)g.A + (size_t)nxt.pm * tstepA : cA; const char* nB = has_next ? (const char*)g.Bt + (size_t)nxt.pn * tstepB : cB;
        for (int t = 0; t < nt; t += 2) {
            const bool last = (t == nt - 2);
            const char* a1 = cA + (size_t)(t + 1) * kstep;
            const char* a2 = last ? nA : cA + (size_t)(t + 2) * kstep; const char* b2 = last ? nB : cB + (size_t)(t + 2) * kstep;
            const char* a3 = a2 + kstep; const char* b3 = b2 + kstep;
            PG8_LDB(B0, 0, 0); PG8_LDB(B1, 0, 1); PG8_SCHED; PG8_LDA(At, 0, 0); PG8_STAGE(PG8_SA(1, 1), a1 + hstepA, voffA);
            PG8_WAIT_V(8); PG8_WAIT_L(0); PG8_BAR; PG8_MMA(0, 0, At, B0); PG8_MMA(0, 1, At, B1); PG8_BAR; PG8_SCHED;
            PG8_LDA(At, 0, 1); PG8_STAGE(PG8_SB(0, 0), b2, voffB); PG8_STAGE(PG8_SB(0, 1), b2 + hstepB, voffB); PG8_STAGE(PG8_SA(0, 0), a2, voffA);
            PG8_WAIT_V(8); PG8_WAIT_L(0); PG8_BAR; PG8_MMA(1, 0, At, B0); PG8_MMA(1, 1, At, B1); PG8_BAR; PG8_SCHED;
            PG8_LDB(B0, 1, 0); PG8_LDB(B1, 1, 1); PG8_SCHED; PG8_LDA(At, 1, 0); PG8_STAGE(PG8_SA(0, 1), a2 + hstepA, voffA);
            PG8_WAIT_V(8); PG8_WAIT_L(0); PG8_BAR; PG8_MMA(0, 0, At, B0); PG8_MMA(0, 1, At, B1); PG8_BAR; PG8_SCHED;
            PG8_LDA(At, 1, 1); PG8_STAGE(PG8_SB(1, 0), b3, voffB); PG8_STAGE(PG8_SB(1, 1), b3 + hstepB, voffB); PG8_STAGE(PG8_SA(1, 0), a3, voffA);
            PG8_WAIT_V(8); PG8_WAIT_L(0); PG8_BAR; PG8_MMA(1, 0, At, B0); PG8_MMA(1, 1, At, B1); PG8_BAR; PG8_SCHED;
        }
        if (wr == 0) PG8_BAR;
        E(acc, cur, wr, wc, fr, fq);
        if (!has_next) break;
#pragma unroll
        for (int a = 0; a < 2; ++a)
#pragma unroll
            for (int b = 0; b < 2; ++b)
#pragma unroll
                for (int m = 0; m < 4; ++m)
#pragma unroll
                    for (int n = 0; n < 2; ++n) acc[a][b][m][n] = (f32x4){0.f, 0.f, 0.f, 0.f};
        cur = nxt; cA = nA; cB = nB; ++ui;
        if (wr == 1) PG8_BAR;
    }
    PG8_WAIT_V(0);
    PG8_BAR;
#undef PG8_SA
#undef PG8_SB
#undef PG8_STAGE
#undef PG8_LDA
#undef PG8_LDB
#undef PG8_MMA
#undef PG8_WAIT_V
#undef PG8_WAIT_L
#undef PG8_BAR
#undef PG8_SCHED
}
}

__device__ __forceinline__ int crow(int r, int hi) { return (r & 3) + 8 * (r >> 2) + 4 * hi; }
__device__ __forceinline__ s16x4 vtr(const LAS unsigned char* p) { typedef short v4i16_t __attribute__((ext_vector_type(4)));
    return __builtin_bit_cast(s16x4, __builtin_amdgcn_ds_read_tr16_b64_v4i16((LAS v4i16_t*)p)); }
constexpr int AT_K0 = 0, AT_K1 = 25600, AT_V0 = 51200, AT_VBUF = 20480, AT_VROW = 320, AT_CNT = AT_V0 + 3 * AT_VBUF;

template <bool SBK>
__device__ __forceinline__ void attn_unit(LAS unsigned char* lds, const bf16* __restrict__ Qp, int ldq, const bf16* __restrict__ Kp, int ldk,
                                          const bf16* __restrict__ Vp, int ldv, bf16* __restrict__ Op, int ldo, int q0, int tid, int wave, int lane) {
    constexpr int DK = SBK ? 128 : 192, NST = DK / 16, KROW = DK * 2 + 16, KCH = DK / 8, NKI = (64 * KCH) / 512;
    asm volatile("" : "+v"(tid), "+v"(lane));
    const int ql = lane & 31, hi = lane >> 5, qw0 = q0 + 32 * wave, myq = qw0 + ql;
    const int nt = (q0 + 256) / 64;
    bf16x8 qf[NST];
    { const bf16* qrow = Qp + (size_t)myq * ldq + 8 * hi;
#pragma unroll
      for (int st = 0; st < NST; ++st) qf[st] = *(const bf16x8*)(qrow + 16 * st); }
    unsigned kgo[NKI], kls[NKI], vgo[2], vls[2];
#pragma unroll
    for (int i = 0; i < NKI; ++i) { const int c = tid + 512 * i, row = c / KCH, cc = c % KCH; kgo[i] = (unsigned)(row * ldk + cc * 8); kls[i] = (unsigned)(row * KROW + cc * 16); }
#pragma unroll
    for (int i = 0; i < 2; ++i) { const int c = tid + 512 * i, row = c >> 4, cc = c & 15; vgo[i] = (unsigned)(row * ldv + cc * 8); vls[i] = (unsigned)(row * AT_VROW + cc * 16); }
    u32x4 kr[NKI], vr[2];
#define AT_LOAD(j) do { const bf16* kp_ = Kp + (size_t)(64 * (j)) * ldk; const bf16* vp_ = Vp + (size_t)(64 * (j)) * ldv; \
        _Pragma("unroll") for (int i = 0; i < NKI; ++i) kr[i] = *(const u32x4*)(kp_ + kgo[i]); \
        _Pragma("unroll") for (int i = 0; i < 2; ++i) vr[i] = *(const u32x4*)(vp_ + vgo[i]); } while (0)
#define AT_STORE(jt) do { LAS unsigned char* kb_ = lds + (((jt) & 1) ? AT_K1 : AT_K0); LAS unsigned char* vb_ = lds + AT_V0 + (SBK ? ((jt) % 3) : ((jt) & 1)) * AT_VBUF; \
        _Pragma("unroll") for (int i = 0; i < NKI; ++i) *(LAS u32x4*)(kb_ + kls[i]) = kr[i]; \
        _Pragma("unroll") for (int i = 0; i < 2; ++i) *(LAS u32x4*)(vb_ + vls[i]) = vr[i]; } while (0)
    f32x16 o[4];
#pragma unroll
    for (int d = 0; d < 4; ++d)
#pragma unroll
        for (int i = 0; i < 16; ++i) o[d][i] = 0.f;
    float m_run = -INFINITY, l_run = 0.f, carry = 1.0f;
    const float qk_scale = SBK ? 0.08838834764831845f : 0.07216878364870323f;
    const float c2 = qk_scale * 1.4426950408889634f;
    const unsigned koff = (unsigned)(ql * KROW + hi * 16);
    const unsigned voff = (unsigned)((4 * hi + ((lane >> 2) & 3)) * AT_VROW + (16 * ((lane >> 4) & 1) + 4 * (lane & 3)) * 2);

    const bool grpB = SBK && wave >= 4; bool pend = false; int jpend = 0;
    unsigned pk[16];
#define AT_PV(jt) do { const LAS unsigned char* vb = lds + AT_V0 + (SBK ? ((jt) % 3) : ((jt) & 1)) * AT_VBUF + voff; \
        _Pragma("unroll") for (int dt = 0; dt < 4; ++dt) { __builtin_amdgcn_sched_barrier(0); \
            _Pragma("unroll") for (int ks = 0; ks < 4; ++ks) { \
                const s16x4 lo = vtr(vb + (16 * ks) * AT_VROW + dt * 64), h4 = vtr(vb + (16 * ks + 8) * AT_VROW + dt * 64); \
                const bf16x8 A = (bf16x8){lo[0], lo[1], lo[2], lo[3], h4[0], h4[1], h4[2], h4[3]}; \
                const u32x4 pw = (u32x4){pk[4 * ks], pk[4 * ks + 1], pk[4 * ks + 2], pk[4 * ks + 3]}; \
                o[dt] = __builtin_amdgcn_mfma_f32_32x32x16_bf16(A, __builtin_bit_cast(bf16x8, pw), o[dt], 0, 0, 0); } } } while (0)
    LAS unsigned* dcnt = (LAS unsigned*)(lds + AT_CNT);
    bool wdone = false;
    if (SBK && tid == 0) { dcnt[0] = 0u; dcnt[1] = 0u; dcnt[2] = 0u; }
    __syncthreads();
    { const int j0 = SBK ? nt - 1 : 0; AT_LOAD(j0); AT_STORE(0); }
    __syncthreads();
#pragma unroll 1
    for (int jj = 0; jj < nt; ++jj) {
        const int j = SBK ? nt - 1 - jj : jj, k0 = 64 * j, b = jj & 1;
        const bool more = (jj + 1 < nt);
        if (more) { const int jn = SBK ? j - 1 : j + 1; AT_LOAD(jn); }
        if (pend) { AT_PV(jpend); pend = false; }
        const bool active = SBK ? (k0 < qw0 + 31 && !wdone) : (k0 <= qw0 + 31);
        if (active) {
            const LAS unsigned char* kb = lds + (b ? AT_K1 : AT_K0) + koff;
            f32x16 s0, s1;
#pragma unroll
            for (int i = 0; i < 16; ++i) { s0[i] = 0.f; s1[i] = 0.f; }
#pragma unroll
            for (int st = 0; st < NST; ++st) {
                const bf16x8 a0 = *(const LAS bf16x8*)(kb + st * 32), a1 = *(const LAS bf16x8*)(kb + 32 * KROW + st * 32);
                s0 = __builtin_amdgcn_mfma_f32_32x32x16_bf16(a0, qf[st], s0, 0, 0, 0);
                s1 = __builtin_amdgcn_mfma_f32_32x32x16_bf16(a1, qf[st], s1, 0, 0, 0);
                if ((st & 3) == 3) __builtin_amdgcn_sched_barrier(0);
            }
            if (!SBK) {
                const bool need_mask = (k0 + 63 > qw0);
                if (need_mask) {
#pragma unroll
                    for (int i = 0; i < 16; ++i) { const int key = k0 + crow(i, hi); if (key > myq) s0[i] = -INFINITY; if (key + 32 > myq) s1[i] = -INFINITY; }
                }
                float mx = s0[0];
#pragma unroll
                for (int i = 1; i < 16; ++i) mx = fmaxf(mx, s0[i]);
#pragma unroll
                for (int i = 0; i < 16; ++i) mx = fmaxf(mx, s1[i]);
                mx = fmaxf(mx, __shfl_xor(mx, 32));
                if (!__all((mx - m_run) * c2 <= 8.0f)) {
                    asm volatile("" ::: "memory");
                    const float m_new = fmaxf(m_run, mx);
                    const float alpha = __builtin_amdgcn_exp2f((m_run - m_new) * c2);
                    m_run = m_new; l_run *= alpha;
#pragma unroll
                    for (int d = 0; d < 4; ++d)
#pragma unroll
                        for (int i = 0; i < 16; ++i) o[d][i] *= alpha;
                }
                const float mc = m_run * c2;
                float ls = 0.f;
#pragma unroll
                for (int i = 0; i < 16; ++i) { s0[i] = __builtin_amdgcn_exp2f(s0[i] * c2 - mc); ls += s0[i]; }
#pragma unroll
                for (int i = 0; i < 16; ++i) { s1[i] = __builtin_amdgcn_exp2f(s1[i] * c2 - mc); ls += s1[i]; }
                l_run += ls;
            } else {
                const bool need_mask = (k0 + 63 >= qw0);
                float omv[32], own[8], par[8];
                const float nsl2 = -qk_scale * 1.4426950408889634f;
#pragma unroll
                for (int sub = 0; sub < 2; ++sub)
#pragma unroll
                    for (int i = 0; i < 16; ++i) {
                        const float z2 = fminf((sub ? s1[i] : s0[i]) * nsl2, 120.0f);
                        const float ex = __builtin_amdgcn_exp2f(z2);
                        float bt = __builtin_amdgcn_rcpf(1.0f + ex);
                        float om = ex * bt;
                        if (need_mask) { const int key = k0 + 32 * sub + crow(i, hi); if (key >= myq) { bt = 0.f; om = 1.0f; } }
                        omv[16 * sub + i] = om;
                        if (sub) s1[i] = bt; else s0[i] = bt;
                    }
#pragma unroll
                for (int m = 0; m < 8; ++m) { own[m] = (omv[4 * m] * omv[4 * m + 1]) * (omv[4 * m + 2] * omv[4 * m + 3]); par[m] = __shfl_xor(own[m], 32); }
                float Tm = 1.0f;
#pragma unroll
                for (int m = 7; m >= 0; --m) {
                    float run = Tm * carry * (hi == 0 ? par[m] : 1.0f);
#pragma unroll
                    for (int r = 3; r >= 0; --r) {
                        const int idx = 4 * m + r;
                        if (idx >= 16) s1[idx - 16] *= run; else s0[idx] *= run;
                        run *= omv[idx];
                    }
                    Tm *= own[m] * par[m];
                }
                carry *= Tm;
            }
#pragma unroll
            for (int js = 0; js < 2; ++js)
#pragma unroll
                for (int w = 0; w < 4; ++w) { pk[4 * js + w] = cvt_pk(s0[8 * js + 2 * w], s0[8 * js + 2 * w + 1]); pk[8 + 4 * js + w] = cvt_pk(s1[8 * js + 2 * w], s1[8 * js + 2 * w + 1]); }
            if (grpB) { pend = true; jpend = jj; } else AT_PV(jj);
        }
        if (SBK) {
            if (!wdone && k0 < qw0 + 31) wdone = __all(carry < 1e-37f);
            if (wdone && lane == 0) __hip_atomic_fetch_add(dcnt + (jj % 3), 1u, __ATOMIC_RELAXED, __HIP_MEMORY_SCOPE_WORKGROUP);
        }
        if (more) AT_STORE(jj + 1);
        __syncthreads();
        if (SBK) {
            if (tid == 0) dcnt[(jj + 2) % 3] = 0u;
            if (dcnt[jj % 3] == 8u) break;
        }
    }
    if (pend) { AT_PV(jpend); pend = false; }
#undef AT_LOAD
#undef AT_STORE
#undef AT_PV
    float inv = 1.0f;
    if (!SBK) { const float lt = l_run + __shfl_xor(l_run, 32); inv = 1.0f / lt; }
    bf16* orow = Op + (size_t)myq * ldo + 4 * hi;
#pragma unroll
    for (int dt = 0; dt < 4; ++dt)
#pragma unroll
        for (int gi = 0; gi < 4; ++gi) {
            u32x2 w; w.x = cvt_pk(o[dt][4 * gi] * inv, o[dt][4 * gi + 1] * inv); w.y = cvt_pk(o[dt][4 * gi + 2] * inv, o[dt][4 * gi + 3] * inv);
            *(u32x2*)(orow + 32 * dt + 8 * gi) = w;
        }
}

struct Args {
    const float *x, *c; const int* pos; const float *w_ada, *b_ada, *g1, *g2, *w_in, *g_ql, *g_kvl, *w_uq, *w_ukv, *g_qh, *g_kh, *w_pa, *w_pb, *w_out, *w_fi, *w_fo;
    float* out; unsigned char* ws;
};

__device__ __forceinline__ void transpose_item(const float* __restrict__ W, int K, int N, bf16* __restrict__ WT, int k0, int n0, int dest_row0, const float* __restrict__ kgain, LAS float* scr, int lane) {
    float tv[32];
#pragma unroll
    for (int i = 0; i < 32; ++i) tv[i] = W[(size_t)(k0 + 2 * i + (lane >> 5)) * N + n0 + (lane & 31)];
    if (kgain) {
#pragma unroll
        for (int i = 0; i < 32; ++i) tv[i] *= kgain[k0 + 2 * i + (lane >> 5)];
    }
#pragma unroll
    for (int i = 0; i < 32; ++i) scr[(2 * i + (lane >> 5)) * 33 + (lane & 31)] = tv[i];
    asm volatile("s_waitcnt lgkmcnt(0)" ::: "memory");
    const int c = lane & 7;
#pragma unroll
    for (int j = 0; j < 4; ++j) { const int n = (lane >> 3) + 8 * j; const LAS float* s = scr + (8 * c) * 33 + n;
        u32x4 o; o.x = cvt_pk(s[0 * 33], s[1 * 33]); o.y = cvt_pk(s[2 * 33], s[3 * 33]); o.z = cvt_pk(s[4 * 33], s[5 * 33]); o.w = cvt_pk(s[6 * 33], s[7 * 33]);
        *(u32x4*)(WT + (size_t)(dest_row0 + n) * K + k0 + 8 * c) = o; }
    asm volatile("s_waitcnt lgkmcnt(0)" ::: "memory");
}

constexpr int CI_IN = (DM / 64) * (DIN / 32), CI_UQ = (512 / 64) * (1536 / 32), CI_UKV = (512 / 64) * (2048 / 32), CI_P = (1024 / 64) * (DM / 32), CI_OUT = (DM / 64) * (DM / 32),
              CI_FI = (DM / 64) * (2 * DFF / 32), CI_FO = (DFF / 64) * (DM / 32);
constexpr int CI_FI_P2 = 1536;
constexpr int CI_FI_P3 = 2048;
constexpr int CI_EARLY = CI_IN + CI_UQ + CI_UKV, CI_LATEA = CI_FO + CI_OUT + 2 * CI_P, CI_ALL = CI_EARLY + CI_LATEA + CI_FI;
__device__ __forceinline__ void convert_item(const Args& a, int it, LAS float* scr, int lane) {
    unsigned char* ws = a.ws;
    int r = it;
    if (r < CI_IN) { const int nblk = DIN / 32, kb = r / nblk, nb = r % nblk; const int n0 = 32 * nb; const int dest = n0 < 1088 ? n0 : n0 + 192;
        transpose_item(a.w_in, DM, DIN, (bf16*)(ws + WS_WIN), 64 * kb, n0, dest, nullptr, scr, lane); return; } r -= CI_IN;
    if (r < CI_UQ) { const int nblk = 1536 / 32, kb = r / nblk, nb = r % nblk; transpose_item(a.w_uq, 512, 1536, (bf16*)(ws + WS_WUQ), 64 * kb, 32 * nb, 32 * nb, a.g_ql, scr, lane); return; } r -= CI_UQ;
    if (r < CI_UKV) { const int nblk = 2048 / 32, kb = r / nblk, nb = r % nblk; transpose_item(a.w_ukv, 512, 2048, (bf16*)(ws + WS_WUKV), 64 * kb, 32 * nb, 32 * nb, a.g_kvl, scr, lane); return; } r -= CI_UKV;
    if (r < CI_FO) { const int nblk = DM / 32, kb = r / nblk, nb = r % nblk; transpose_item(a.w_fo, DFF, DM, (bf16*)(ws + WS_WFO), 64 * kb, 32 * nb, 32 * nb, nullptr, scr, lane); return; } r -= CI_FO;
    if (r < CI_OUT) { const int nblk = DM / 32, kb = r / nblk, nb = r % nblk; transpose_item(a.w_out, DM, DM, (bf16*)(ws + WS_WOUT), 64 * kb, 32 * nb, 32 * nb, nullptr, scr, lane); return; } r -= CI_OUT;
    if (r < CI_P) { const int nblk = DM / 32, kb = r / nblk, nb = r % nblk; transpose_item(a.w_pa, 1024, DM, (bf16*)(ws + WS_WPA), 64 * kb, 32 * nb, 32 * nb, nullptr, scr, lane); return; } r -= CI_P;
    if (r < CI_P) { const int nblk = DM / 32, kb = r / nblk, nb = r % nblk; transpose_item(a.w_pb, 1024, DM, (bf16*)(ws + WS_WPB), 64 * kb, 32 * nb, 32 * nb, nullptr, scr, lane); return; } r -= CI_P;
    { const int nblk = 2 * DFF / 32, kb = r / nblk, nb = r % nblk; const int n0 = 32 * nb; const int jn = n0 < DFF ? n0 : n0 - DFF;
      const int dest = 256 * (jn / 128) + (jn % 128) + (n0 < DFF ? 0 : 128);
      transpose_item(a.w_fi, DM, 2 * DFF, (bf16*)(ws + WS_WFI), 64 * kb, n0, dest, nullptr, scr, lane); }
}

__device__ __forceinline__ void p0_prologue(const Args& a, LAS unsigned char* lds, int gw, int NGW, int wave, int lane) {
    unsigned char* ws = a.ws;
    float* part = (float*)(ws + WS_Y);
    for (int it = gw; it < 48 * NPART; it += NGW) {
        const int cgp = it % 48, kc = it / 48;
        float sv[4];
#pragma unroll
        for (int b = 0; b < 4; ++b) { const float cv = a.c[b * DM + kc * 64 + lane]; sv[b] = cv * fast_sigmoid(cv); }
        f32x4 acc[4];
#pragma unroll
        for (int b = 0; b < 4; ++b) acc[b] = (f32x4){0.f, 0.f, 0.f, 0.f};
        const float* wp = a.w_ada + (size_t)(kc * 64) * ADA_N + cgp * 256 + lane * 4;
#pragma unroll 8
        for (int kk = 0; kk < 64; ++kk) {
            const f32x4 w = *(const f32x4*)(wp + (size_t)kk * ADA_N);
#pragma unroll
            for (int b = 0; b < 4; ++b) { const float s = __uint_as_float(__builtin_amdgcn_readlane(__float_as_uint(sv[b]), kk)); acc[b] += w * s; }
        }
#pragma unroll
        for (int b = 0; b < 4; ++b) *(f32x4*)(part + (size_t)(kc * 4 + b) * ADA_N + cgp * 256 + lane * 4) = acc[b];
    }
    LAS float* scr = (LAS float*)(lds + wave * 8704);
    for (int it = gw; it < CI_EARLY + CI_FI - CI_FI_P3 - CI_FI_P2; it += NGW) convert_item(a, it < CI_EARLY ? it : it + CI_LATEA, scr, lane);
    bf16* Win = (bf16*)(a.ws + WS_WIN);
    for (int p = gw * 64 + lane; p < 192 * DM / 8; p += NGW * 64) *(u32x4*)(Win + (size_t)1088 * DM + (size_t)p * 8) = (u32x4){0u, 0u, 0u, 0u};
}

__device__ __forceinline__ void norm_rows(const float* __restrict__ src, bf16* __restrict__ dst, const LAS float* scale, const LAS float* shift, int row0, int wave, int lane) {
#pragma unroll 1
    for (int r = 0; r < 8; ++r) {
        const int row = row0 + wave * 8 + r;
        const f32x4* xr = (const f32x4*)(src + (size_t)row * DM) + lane;
        f32x4 v[8]; float ss = 0.f;
#pragma unroll
        for (int j = 0; j < 8; ++j) { v[j] = xr[64 * j]; ss += (v[j].x * v[j].x + v[j].y * v[j].y) + (v[j].z * v[j].z + v[j].w * v[j].w); }
        const float rstd = 1.0f / sqrtf(wave_sum(ss) * (1.0f / DM) + EPS);
        u32x2* orow = (u32x2*)(dst + (size_t)row * DM) + lane;
#pragma unroll
        for (int j = 0; j < 8; ++j) { const int col = 4 * (64 * j + lane); const f32x4 sc = *(const LAS f32x4*)(scale + col), sh = *(const LAS f32x4*)(shift + col);
            const f32x4 y = v[j] * rstd * sc + sh; u32x2 w; w.x = cvt_pk(y.x, y.y); w.y = cvt_pk(y.z, y.w); orow[64 * j] = w; }
    }
}

#define XB_TMO      128
#define XB_XCNT(j)  (256  + 64 * (j))
#define XB_XSUB(j)  (1280 + 64 * (j))
#define XB_XGEN(j)  (2304 + 64 * (j))
#define XB_TOP      3328
#define XB_TOPGEN   3392
#define XCD_BAR_WORDS 3456
#define XB_SPIN_CAP (1u << 20)
__device__ __forceinline__ unsigned xb_ld(unsigned* p)              { return __hip_atomic_load(p, __ATOMIC_RELAXED, __HIP_MEMORY_SCOPE_AGENT); }
__device__ __forceinline__ unsigned xb_add(unsigned* p, unsigned v) { return __hip_atomic_fetch_add(p, v, __ATOMIC_RELAXED, __HIP_MEMORY_SCOPE_AGENT); }
__device__ __forceinline__ unsigned xb_xcc_id() { return (unsigned)__builtin_amdgcn_s_getreg((3 << 11) | 20) & 0xFu; }
#define XB_SPIN(cond, bar) do { unsigned _sp = 0; while (cond) { __builtin_amdgcn_s_sleep(1); \
    if ((++_sp & 255u) == 0u) { if (xb_ld(&(bar)[XB_TMO])) break; if (_sp > XB_SPIN_CAP) { atomicAdd(&(bar)[XB_TMO], 1u); break; } } } } while (0)
struct XcdBarrier { unsigned* bar; unsigned x; volatile LAS unsigned* st; };
__device__ __forceinline__ XcdBarrier xcd_barrier_post(unsigned* bar, volatile LAS unsigned* st) {
    XcdBarrier b; b.bar = bar; b.x = xb_xcc_id(); b.st = st;
    if (threadIdx.x == 0) st[3] = xb_add(&bar[XB_XCNT(b.x)], 1u);
    return b;
}
__device__ __forceinline__ void xcd_barrier_complete(unsigned* bar, unsigned x, unsigned& nloc, unsigned& nx, unsigned& even32) {
    const unsigned G = gridDim.x * gridDim.y * gridDim.z;
    unsigned sum, cnt, mine, sp = 0u;
    for (;;) {
        sum = 0u; cnt = 0u; mine = 0u; even32 = 1u;
#pragma unroll
        for (unsigned j = 0; j < 16; ++j) { const unsigned c = xb_ld(&bar[XB_XCNT(j)]); sum += c; cnt += (c > 0u) ? 1u : 0u; mine = (j == x) ? c : mine; if (c != 0u && c != 32u) even32 = 0u; }
        if (sum == G) break;
        __builtin_amdgcn_s_sleep(1);
        if ((++sp & 255u) == 0u) { if (xb_ld(&bar[XB_TMO])) break; if (sp > XB_SPIN_CAP) { atomicAdd(&bar[XB_TMO], 1u); break; } }
    }
    nloc = mine > 0u ? mine : 1u; nx = cnt > 0u ? cnt : 1u;
}
__device__ __forceinline__ void xcd_barrier(const XcdBarrier& b) {
    asm volatile("s_waitcnt vmcnt(0)" ::: "memory");
    __syncthreads();
    if (threadIdx.x == 0) {
        unsigned* bar = b.bar;
        __builtin_amdgcn_s_waitcnt(0);
        unsigned nloc = b.st[0], nx = b.st[1];
        if (nloc == 0u) { unsigned e32; xcd_barrier_complete(bar, b.x, nloc, nx, e32); b.st[0] = nloc; b.st[1] = nx;
            b.st[2] = (e32 && nx == 8u && gridDim.x == 256u && !xb_ld(&bar[XB_TMO])) ? 1u : 0u; }
        const unsigned old = xb_add(&bar[XB_XSUB(b.x)], 1u);
        const unsigned gen = old / nloc;
        if (old + 1u == (gen + 1u) * nloc) {
            __builtin_amdgcn_fence(__ATOMIC_RELEASE, "agent");
            asm volatile("s_waitcnt vmcnt(0)" ::: "memory");
            const unsigned og = xb_add(&bar[XB_TOP], 1u);
            const unsigned tg = og / nx;
            if (og + 1u == (tg + 1u) * nx) xb_add(&bar[XB_TOPGEN], 1u);
            else XB_SPIN(xb_ld(&bar[XB_TOPGEN]) == tg, bar);
            __builtin_amdgcn_fence(__ATOMIC_ACQUIRE, "agent");
            xb_add(&bar[XB_XGEN(b.x)], 1u);
            asm volatile("s_waitcnt vmcnt(0)" ::: "memory");
        } else {
            XB_SPIN(xb_ld(&bar[XB_XGEN(b.x)]) == gen, bar);
            __builtin_amdgcn_fence(__ATOMIC_ACQUIRE, "agent");
            asm volatile("s_waitcnt vmcnt(0)" ::: "memory");
        }
    }
    __syncthreads();
}

#define XL_SUB(j) (4096 + 64 * (j))
#define XL_GEN(j) (5120 + 64 * (j))
__device__ __forceinline__ void xcc_local_barrier(const XcdBarrier& b) {
    asm volatile("s_waitcnt vmcnt(0)" ::: "memory");
    __syncthreads();
    if (threadIdx.x == 0) {
        unsigned* bar = b.bar;
        __builtin_amdgcn_s_waitcnt(0);
        const unsigned old = xb_add(&bar[XL_SUB(b.x)], 1u);
        const unsigned gen = old / 32u;
        if (old + 1u == (gen + 1u) * 32u) xb_add(&bar[XL_GEN(b.x)], 1u);
        else XB_SPIN(xb_ld(&bar[XL_GEN(b.x)]) == gen, bar);
        __builtin_amdgcn_fence(__ATOMIC_ACQUIRE, "agent");
        asm volatile("s_waitcnt vmcnt(0)" ::: "memory");
    }
    __syncthreads();
}

__global__ void __launch_bounds__(512, 2) fwd_megakernel(Args a) {
    extern __shared__ __attribute__((aligned(16))) unsigned char lds_raw[];
    LAS unsigned char* lds = (LAS unsigned char*)lds_raw;
    cg::grid_group grid = cg::this_grid();
    const int tid = threadIdx.x, lane = tid & 63, wave = __builtin_amdgcn_readfirstlane(tid >> 6);
    const int G = gridDim.x, bx = blockIdx.x;
    const int vcu = (G % 8 == 0) ? (bx % 8) * (G / 8) + bx / 8 : bx;
    const int gw = vcu * 8 + wave, NGW = G * 8;
    unsigned char* ws = a.ws;
    float* ada = (float*)(ws + WS_ADA);
    float* part = (float*)(ws + WS_Y);
    bf16* Win = (bf16*)(ws + WS_WIN); bf16* Wuq = (bf16*)(ws + WS_WUQ); bf16* Wukv = (bf16*)(ws + WS_WUKV); bf16* Wpa = (bf16*)(ws + WS_WPA); bf16* Wpb = (bf16*)(ws + WS_WPB);
    bf16* Wout = (bf16*)(ws + WS_WOUT); bf16* Wfi = (bf16*)(ws + WS_WFI); bf16* Wfo = (bf16*)(ws + WS_WFO);
    bf16* proj = (bf16*)(ws + WS_PROJ); bf16* act = (bf16*)(ws + WS_PROJ);
    bf16* kvraw = (bf16*)(ws + WS_KVRAW); bf16* merged = (bf16*)(ws + WS_KVRAW);
    bf16* ybuf = (bf16*)(ws + WS_Y); bf16* h2 = (bf16*)(ws + WS_Y);
    bf16* hbuf = (bf16*)a.out; bf16* qbuf = (bf16*)((unsigned char*)a.out + DO_Q); bf16* kbuf = (bf16*)a.out;
    LAS float* tscale = (LAS float*)lds; LAS float* tshift = (LAS float*)(lds + 8192);
    volatile LAS unsigned* bst = (volatile LAS unsigned*)(lds + LDS_MISC);
    if (tid == 0) { bst[0] = 0u; bst[1] = 0u; bst[2] = 0u; bst[3] = 0u; }
    __syncthreads();
    const XcdBarrier xbar = xcd_barrier_post(g_ctl, bst);
#define PROBE_SEL -1
#define PROBE_K 8
    int n_stamp = 0;
#define STAMP() do { if (PROBE_SEL >= 0) { if (tid == 0) ((volatile LAS unsigned long long*)(lds + LDS_MISC + 64))[n_stamp] = __builtin_amdgcn_s_memrealtime(); ++n_stamp; } } while (0)
#define GRID_BAR() do { xcd_barrier(xbar); STAMP(); } while (0)
#define LOCAL_BAR() do { if (local_ok) xcc_local_barrier(xbar); else xcd_barrier(xbar); STAMP(); } while (0)
    STAMP();

    p0_prologue(a, lds, gw, NGW, wave, lane);
    if (a.ws == nullptr) grid.sync();
    GRID_BAR();

    const bool local_ok = bst[2] != 0u;
    const int cidx = local_ok ? (int)(bst[3] * 8u + xbar.x) : bx;
    const int rowblk = local_ok ? (int)(xbar.x * 32u + bst[3]) : bx;
    for (int e = bx * 512 + tid; e < NB * ADA_N; e += G * 512) { const int b = e / ADA_N, n = e % ADA_N; float v = a.b_ada[n];
        for (int p = 0; p < NPART; ++p) v += part[(size_t)(p * 4 + b) * ADA_N + n];
        ada[e] = v; }
    for (int ch = rowblk; ch < T / 64; ch += G) {
        const int b = (ch * 64) / SEQ;
        __syncthreads();
        for (int d = tid; d < DM; d += 512) { float sh = a.b_ada[d], sc = a.b_ada[DM + d];
            for (int p = 0; p < NPART; ++p) { sh += part[(size_t)(p * 4 + b) * ADA_N + d]; sc += part[(size_t)(p * 4 + b) * ADA_N + DM + d]; }
            tscale[d] = a.g1[d] * (1.0f + sc); tshift[d] = sh; }
        __syncthreads();
        norm_rows(a.x, hbuf, tscale, tshift, ch * 64, wave, lane);
    }
    LOCAL_BAR();

    { pg8::Gemm g{hbuf, Win, T, PLD, DM, DM, DM}; pg8::StaticOrder S; S.init(T, PLD, G, cidx); pg8::EpiBf16 E{proj, PLD}; pg8::gemm_phase(lds, g, S, E);
      const int nun = (T / 256) * (PLD / 256), rem = nun % G, npart = rem ? G - rem : G, rank = rem ? cidx - rem : cidx;
      if (rank >= 0) { LAS float* scr = (LAS float*)(lds + wave * 8704);
          for (int it = rank * 8 + wave; it < CI_LATEA + CI_FI_P2; it += npart * 8) convert_item(a, it < CI_LATEA ? CI_EARLY + it : CI_EARLY + CI_LATEA + (CI_FI - CI_FI_P3 - CI_FI_P2) + (it - CI_LATEA), scr, lane); } }
    LOCAL_BAR();

    { pg8::Gemm g{proj, Wuq, T, 1536, 512, PLD, 512}; pg8::StaticOrder S; S.init(T, 1536, G, cidx); pg8::EpiBf16 E{qbuf, 1536}; pg8::gemm_phase(lds, g, S, E); }
    { pg8::Gemm g{proj + 512, Wukv, T, 2048, 512, PLD, 512}; pg8::StaticOrder S; S.init(T, 2048, G, cidx); pg8::EpiBf16 E{kvraw, 2048}; pg8::gemm_phase(lds, g, S, E); }
    {
      const int nq = (T / 256) * (1536 / 256), rem = nq % G, npart = rem ? G - rem : G, rank = rem ? cidx - rem : cidx;
      if (rank >= 0) { LAS float* scr = (LAS float*)(lds + wave * 8704);
          for (int it = rank * 8 + wave; it < CI_FI_P3; it += npart * 8) convert_item(a, CI_EARLY + CI_LATEA + CI_FI - CI_FI_P3 + it, scr, lane); } }
    LOCAL_BAR();

    { const int hd = lane >> 3, j = lane & 7;
      float gq[24], gk[24], fq_[8];
#pragma unroll
      for (int c = 0; c < 3; ++c)
#pragma unroll
          for (int e2 = 0; e2 < 8; ++e2) { gq[8 * c + e2] = a.g_qh[64 * c + 8 * j + e2]; gk[8 * c + e2] = a.g_kh[64 * c + 8 * j + e2]; }
#pragma unroll
      for (int e2 = 0; e2 < 8; ++e2) fq_[e2] = ROPE_FREQ[8 * (j & 3) + e2];
#define UNPK8(u, f) do { f[0] = bf_lo(u.x); f[1] = bf_hi(u.x); f[2] = bf_lo(u.y); f[3] = bf_hi(u.y); f[4] = bf_lo(u.z); f[5] = bf_hi(u.z); f[6] = bf_lo(u.w); f[7] = bf_hi(u.w); } while (0)
#define PK8(f) ((u32x4){cvt_pk(f[0], f[1]), cvt_pk(f[2], f[3]), cvt_pk(f[4], f[5]), cvt_pk(f[6], f[7])})
#pragma unroll 2
      for (int tk = 0; tk < (T + NGW - 1) / NGW; ++tk) { const int t = local_ok ? (rowblk * 8 + wave) * 8 + tk : gw + tk * NGW; if (t >= T) break;
        const bf16* prow = proj + (size_t)t * PLD;
        bf16* qrow = qbuf + (size_t)t * 1536 + hd * DQK + 8 * j; bf16* krow = kbuf + (size_t)t * 2048 + hd * DQK + 8 * j; bf16* kvrow = kvraw + (size_t)t * 2048 + hd * 256;
        const u32x4 ulq = *(const u32x4*)(prow + lane * 8), ulk = *(const u32x4*)(prow + 512 + lane * 8), upe = *(const u32x4*)(prow + C_KPE + 8 * j);
        const u32x4 uq0 = *(const u32x4*)(qrow), uq1 = *(const u32x4*)(qrow + 64), uq2 = *(const u32x4*)(qrow + 128);
        const u32x4 uk0 = *(const u32x4*)(kvrow + 8 * j), uk1 = *(const u32x4*)(kvrow + 64 + 8 * j);
        const u32x4 uv0 = *(const u32x4*)(kvrow + 128 + 16 * j), uv1 = *(const u32x4*)(kvrow + 136 + 16 * j);
        const float posf = (float)a.pos[t];
        float tf[8]; float aq, akv;
        { UNPK8(ulq, tf); float s2 = 0.f;
#pragma unroll
          for (int e2 = 0; e2 < 8; ++e2) s2 += tf[e2] * tf[e2];
          aq = 1.0f / sqrtf(wave_sum(s2) * (1.0f / 512.0f) + EPS); }
        { UNPK8(ulk, tf); float s2 = 0.f;
#pragma unroll
          for (int e2 = 0; e2 < 8; ++e2) s2 += tf[e2] * tf[e2];
          akv = 1.0f / sqrtf(wave_sum(s2) * (1.0f / 512.0f) + EPS); }
        float cs[8], sn[8];
#pragma unroll
        for (int e2 = 0; e2 < 8; ++e2) { const float ang = posf * fq_[e2]; double rev = (double)ang * 0.15915494309189535; rev -= __builtin_rint(rev);
            sn[e2] = __builtin_amdgcn_sinf((float)rev); cs[e2] = __builtin_amdgcn_cosf((float)rev); }
        { float x0[8], x1[8], x2[8]; UNPK8(uq0, x0); UNPK8(uq1, x1); UNPK8(uq2, x2); float s2 = 0.f;
#pragma unroll
          for (int e2 = 0; e2 < 8; ++e2) { x0[e2] *= aq; x1[e2] *= aq; x2[e2] *= aq; s2 += x0[e2] * x0[e2] + x1[e2] * x1[e2] + x2[e2] * x2[e2]; }
          s2 += __shfl_xor(s2, 1); s2 += __shfl_xor(s2, 2); s2 += __shfl_xor(s2, 4);
          const float rstd = 1.0f / sqrtf(s2 * (1.0f / DQK) + EPS);
#pragma unroll
          for (int e2 = 0; e2 < 8; ++e2) { x0[e2] *= rstd * gq[e2]; x1[e2] *= rstd * gq[8 + e2]; const float f2 = x2[e2] * rstd * gq[16 + e2], pf = __shfl_xor(f2, 4);
              x2[e2] = j < 4 ? f2 * cs[e2] - pf * sn[e2] : pf * sn[e2] + f2 * cs[e2]; }
          *(u32x4*)(qrow) = PK8(x0); *(u32x4*)(qrow + 64) = PK8(x1); *(u32x4*)(qrow + 128) = PK8(x2); }
        { float x0[8], x1[8], x2[8]; UNPK8(uk0, x0); UNPK8(uk1, x1); UNPK8(upe, x2); float s2 = 0.f;
#pragma unroll
          for (int e2 = 0; e2 < 8; ++e2) { x0[e2] *= akv; x1[e2] *= akv; s2 += x0[e2] * x0[e2] + x1[e2] * x1[e2] + x2[e2] * x2[e2]; }
          s2 += __shfl_xor(s2, 1); s2 += __shfl_xor(s2, 2); s2 += __shfl_xor(s2, 4);
          const float rstd = 1.0f / sqrtf(s2 * (1.0f / DQK) + EPS);
#pragma unroll
          for (int e2 = 0; e2 < 8; ++e2) { x0[e2] *= rstd * gk[e2]; x1[e2] *= rstd * gk[8 + e2]; const float f2 = x2[e2] * rstd * gk[16 + e2], pf = __shfl_xor(f2, 4);
              x2[e2] = j < 4 ? f2 * cs[e2] - pf * sn[e2] : pf * sn[e2] + f2 * cs[e2]; }
          *(u32x4*)(krow) = PK8(x0); *(u32x4*)(krow + 64) = PK8(x1); *(u32x4*)(krow + 128) = PK8(x2); }
        { float x0[8], x1[8]; UNPK8(uv0, x0); UNPK8(uv1, x1);
#pragma unroll
          for (int e2 = 0; e2 < 8; ++e2) { x0[e2] *= akv; x1[e2] *= akv; }
          *(u32x4*)(kvrow + 128 + 16 * j) = PK8(x0); *(u32x4*)(kvrow + 136 + 16 * j) = PK8(x1); }
      }
#undef UNPK8
#undef PK8
    }
    GRID_BAR();

    for (int su = vcu; su < 256; su += G) {
        const int bh = su >> 3, p = su & 7, b = bh >> 3, h = bh & 7;
        const size_t r0 = (size_t)b * SEQ;
#pragma unroll 1
        for (int half = 0; half < 2; ++half) { const int qb = half ? p : 15 - p;
            attn_unit<false>(lds, qbuf + r0 * 1536 + h * DQK, 1536, kbuf + r0 * 2048 + h * DQK, 2048, kvraw + r0 * 2048 + h * 256 + 128, 2048, ybuf + r0 * DM + h * 128, DM, qb * 256, tid, wave, lane);
        }
#pragma unroll 1
        for (int half = 0; half < 2; ++half) { const int qb = half ? p : 15 - p;
            attn_unit<true>(lds, proj + r0 * PLD + C_SBQ + h * 128, PLD, proj + r0 * PLD + C_SBK + h * 128, PLD, proj + r0 * PLD + C_SBV + h * 128, PLD, ybuf + r0 * DM + 1024 + h * 128, DM, qb * 256, tid, wave, lane);
        }
    }
    GRID_BAR();

    { pg8::Gemm g{ybuf, Wpa, T, DM, 1024, DM, 1024}; pg8::StaticOrder S; S.init(T, DM, G, cidx); pg8::EpiGate<false> E{merged, DM, proj + C_GA, PLD}; pg8::gemm_phase(lds, g, S, E); }
    { pg8::Gemm g{ybuf + 1024, Wpb, T, DM, 1024, DM, 1024}; pg8::StaticOrder S; S.init(T, DM, G, cidx); pg8::EpiGate<true> E{merged, DM, proj + C_GB, PLD}; pg8::gemm_phase(lds, g, S, E); }
    LOCAL_BAR();

    { pg8::Gemm g{merged, Wout, T, DM, DM, DM, DM}; pg8::StaticOrder S; S.init(T, DM, G, cidx); pg8::EpiRes E{a.x, a.out, ada + 2 * DM, ADA_N}; pg8::gemm_phase(lds, g, S, E); }
    LOCAL_BAR();

    for (int ch = rowblk; ch < T / 64; ch += G) {
        const int b = (ch * 64) / SEQ;
        __syncthreads();
        for (int d = tid; d < DM; d += 512) { tscale[d] = a.g2[d] * (1.0f + ada[b * ADA_N + 4 * DM + d]); tshift[d] = ada[b * ADA_N + 3 * DM + d]; }
        __syncthreads();
        norm_rows(a.out, h2, tscale, tshift, ch * 64, wave, lane);
    }
    LOCAL_BAR();

    { pg8::Gemm g{h2, Wfi, T, 2 * DFF, DM, DM, DM}; pg8::StaticOrder S; S.init(T, 2 * DFF, G, cidx); pg8::EpiSwiglu E{act, PLD}; pg8::gemm_phase(lds, g, S, E); }
    LOCAL_BAR();

    { pg8::Gemm g{act, Wfo, T, DM, DFF, PLD, DFF}; pg8::StaticOrder S; S.init(T, DM, G, cidx); pg8::EpiRes E{a.out, a.out, ada + 5 * DM, ADA_N}; pg8::gemm_phase(lds, g, S, E); }
    STAMP();
    if (PROBE_SEL >= 0) {
        if (tid == 0) { volatile LAS unsigned long long* st = (volatile LAS unsigned long long*)(lds + LDS_MISC + 64);
            const unsigned long long d = (st[PROBE_SEL + 1] - st[PROBE_SEL]) * PROBE_K, t0 = __builtin_amdgcn_s_memrealtime();
            while (__builtin_amdgcn_s_memrealtime() - t0 < d) __builtin_amdgcn_s_sleep(8); }
        __syncthreads();
    }
    { volatile LAS unsigned* lastf = (volatile LAS unsigned*)(lds + LDS_MISC + 48);
      asm volatile("s_waitcnt vmcnt(0)" ::: "memory");
      __syncthreads();
      if (tid == 0) *lastf = (xb_add(&g_ctl[8128], 1u) == (unsigned)G - 1u) ? 1u : 0u;
      __syncthreads();
      if (*lastf) { for (int i = tid; i < 8192; i += 512) __hip_atomic_store(&g_ctl[i], 0u, __ATOMIC_RELAXED, __HIP_MEMORY_SCOPE_AGENT); } }
}

constexpr int LDS_BYTES = 147456;
extern "C" void kernel_launch(void* const* d_in, const int* in_sizes, int n_in, void* d_out, int out_size, void* d_ws, size_t ws_size, hipStream_t stream) {
    static int grid = 0;
    if (grid == 0) {
        if (n_in != 19 || out_size != T * DM || ws_size < WS_END) { fprintf(stderr, "kernel_launch: unexpected problem (n_in %d out %d ws %zu)\n", n_in, out_size, ws_size); grid = -1; return; }
        int dev = 0, cus = 0, per_cu = 0;
        hipGetDevice(&dev); hipDeviceGetAttribute(&cus, hipDeviceAttributeMultiprocessorCount, dev);
        if (hipFuncSetAttribute((const void*)fwd_megakernel, hipFuncAttributeMaxDynamicSharedMemorySize, LDS_BYTES) != hipSuccess) { fprintf(stderr, "kernel_launch: hipFuncSetAttribute failed\n"); grid = -1; return; }
        if (hipOccupancyMaxActiveBlocksPerMultiprocessor(&per_cu, (const void*)fwd_megakernel, 512, LDS_BYTES) != hipSuccess || per_cu < 1) { fprintf(stderr, "kernel_launch: occupancy query failed (%d)\n", per_cu); per_cu = 1; }
        (void)hipGetLastError();
        grid = cus * (per_cu > 1 ? 1 : per_cu);
    }
    if (grid < 0) return;
    Args a{};
    a.x = (const float*)d_in[0]; a.c = (const float*)d_in[1]; a.pos = (const int*)d_in[2]; a.w_ada = (const float*)d_in[3]; a.b_ada = (const float*)d_in[4];
    a.g1 = (const float*)d_in[5]; a.g2 = (const float*)d_in[6]; a.w_in = (const float*)d_in[7]; a.g_ql = (const float*)d_in[8]; a.g_kvl = (const float*)d_in[9];
    a.w_uq = (const float*)d_in[10]; a.w_ukv = (const float*)d_in[11]; a.g_qh = (const float*)d_in[12]; a.g_kh = (const float*)d_in[13]; a.w_pa = (const float*)d_in[14];
    a.w_pb = (const float*)d_in[15]; a.w_out = (const float*)d_in[16]; a.w_fi = (const float*)d_in[17]; a.w_fo = (const float*)d_in[18];
    a.out = (float*)d_out; a.ws = (unsigned char*)d_ws;
    void* args[] = {&a};
    hipError_t e = hipLaunchCooperativeKernel((const void*)fwd_megakernel, dim3(grid), dim3(512), args, LDS_BYTES, stream);
    if (e != hipSuccess) fprintf(stderr, "kernel_launch: cooperative launch failed: %s (grid %d)\n", hipGetErrorString(e), grid);
}
```

```cpp
#include <hip/hip_runtime.h>
#include <hip/hip_cooperative_groups.h>
#include <cstdio>
#include <cstdint>
namespace cg = cooperative_groups;

#define LAS __attribute__((address_space(3)))
typedef unsigned short bf16;
typedef short bf16x8 __attribute__((ext_vector_type(8)));
typedef short s16x4 __attribute__((ext_vector_type(4)));
typedef float f32x2 __attribute__((ext_vector_type(2)));
typedef float f32x4 __attribute__((ext_vector_type(4)));
typedef float f32x16 __attribute__((ext_vector_type(16)));
typedef unsigned u32x4 __attribute__((ext_vector_type(4)));
typedef unsigned u32x2 __attribute__((ext_vector_type(2)));
typedef __bf16 bf16x2_t __attribute__((ext_vector_type(2)));

constexpr int NB = 4, SEQ = 4096, T = NB * SEQ, DM = 2048;
constexpr int NH = 8, DQK = 192, DFF = 5632, DIN = 8256, PLD = 8448;
constexpr int C_KPE = 1024, C_SBQ = 1280, C_SBK = 2304, C_SBV = 3328, C_GA = 4352, C_GB = 6400;
constexpr int ADA_N = 6 * DM;
constexpr int NPART = 32;
constexpr float EPS = 1e-6f;
constexpr size_t MiB = 1u << 20;
constexpr int LDS_MISC = 131072 + 512;
constexpr size_t WS_ADA = 0;
constexpr size_t WS_WIN = 1 * MiB, WS_WUQ = 34 * MiB, WS_WUKV = 36 * MiB, WS_WPA = 38 * MiB, WS_WPB = 42 * MiB, WS_WOUT = 46 * MiB, WS_WFI = 54 * MiB, WS_WFO = 98 * MiB;
constexpr size_t WS_PROJ = 120 * MiB;
constexpr size_t WS_KVRAW = 384 * MiB;
constexpr size_t WS_Y = 448 * MiB;
constexpr size_t WS_END = 512 * MiB;
constexpr size_t DO_Q = 64 * MiB;

__device__ unsigned g_ctl[8192];
__device__ const float ROPE_FREQ[32] = {1.0f, 0.7498942613601685f, 0.5623413324356079f, 0.4216965138912201f, 0.3162277638912201f, 0.23713737726211548f, 0.17782793939113617f, 0.133352130651474f,
    0.10000000149011612f, 0.07498941570520401f, 0.05623413249850273f, 0.04216965287923813f, 0.03162277489900589f, 0.023713737726211548f, 0.017782794311642647f, 0.01333521492779255f,
    0.009999999776482582f, 0.007498941849917173f, 0.005623413249850273f, 0.0042169648222625256f, 0.003162277629598975f, 0.00237137358635664f, 0.0017782794311642647f, 0.0013335214462131262f,
    0.0010000000474974513f, 0.0007498942431993783f, 0.000562341301701963f, 0.0004216965171508491f, 0.0003162277571391314f, 0.00023713737027719617f, 0.00017782794020604342f, 0.0001333521504420787f};

__device__ __forceinline__ unsigned cvt_pk(float lo, float hi) { f32x2 v = {lo, hi}; bf16x2_t b = __builtin_convertvector(v, bf16x2_t); return __builtin_bit_cast(unsigned, b); }
__device__ __forceinline__ float bf_lo(unsigned u) { return __uint_as_float(u << 16); }
__device__ __forceinline__ float bf_hi(unsigned u) { return __uint_as_float(u & 0xffff0000u); }
__device__ __forceinline__ float bf2f(bf16 b) { return __uint_as_float((unsigned)b << 16); }
__device__ __forceinline__ bf16 f2bf(float f) { return (bf16)(cvt_pk(f, 0.f) & 0xffffu); }
__device__ __forceinline__ float wave_sum(float v) {
#pragma unroll
    for (int o = 1; o < 64; o <<= 1) v += __shfl_xor(v, o);
    return v;
}
__device__ __forceinline__ float xhalf(float v) {
    const auto rr = __builtin_amdgcn_permlane32_swap(__float_as_uint(v), __float_as_uint(v), false, false);
    return __uint_as_float((threadIdx.x & 32) ? rr[0] : rr[1]);
}
__device__ __forceinline__ float fast_sigmoid(float x) { return __builtin_amdgcn_rcpf(1.0f + __expf(-x)); }

namespace pg8 {
constexpr int BM = 256, BK = 64, HALF = 128, HTB = HALF * BK * 2, STAGE_BYTES = 8 * HTB, NXCD = 8, WGM = 8;
__host__ __device__ __forceinline__ int lds_byte(int r, int c) { const int st = (r >> 4) * 2 + (c >> 5), rr = r & 15, cc = c & 31, ob = rr * 64 + cc * 2; return st * 1024 + (ob ^ (((ob >> 9) & 1) << 5)); }
__host__ __device__ __forceinline__ void stage_rc(int b, int& R, int& C) { const int st = b / 1024, sb = b % 1024, swz = sb ^ (((sb >> 9) & 1) << 5); R = (st >> 1) * 16 + swz / 64; C = (st & 1) * 32 + (swz % 64) / 2; }
__host__ __device__ __forceinline__ int perm32(int rho) { const int n = rho >> 4, i = rho & 15; return 8 * (i >> 2) + 4 * n + (i & 3); }
struct Unit { int pm, pn; };
struct Gemm { const bf16* A; const bf16* Bt; int M, N, K, lda, ldb; };
struct StaticOrder {
    int nM, nN, nwg, G, c;
    __device__ void init(int M, int N, int G_, int c_) { nM = M / BM; nN = N / BM; nwg = nM * nN; G = G_; c = c_; }
    __device__ bool next(int i, Unit& u) const {
        const long L = (long)i * G + c; if (L >= nwg) return false;
        int wgid = (int)L; { const int q = nwg / NXCD, r = nwg % NXCD, xcd = wgid % NXCD, off = wgid / NXCD; wgid = (xcd < r ? xcd * (q + 1) : r * (q + 1) + (xcd - r) * q) + off; }
        const int nig = WGM * nN, gid = wgid / nig, fm = gid * WGM, gsz = (nM - fm) < WGM ? (nM - fm) : WGM;
        u.pm = fm + ((wgid % nig) % gsz); u.pn = (wgid % nig) / gsz; return true;
    }
};
typedef f32x4 Acc[2][2][4][2];

struct EpiBf16 {
    bf16* O; int ldc;
    __device__ __forceinline__ void operator()(const Acc& acc, const Unit& u, int wr, int wc, int fr, int fq) const {
        const int row0 = u.pm * BM + wr * 64 + fr, col0 = u.pn * BM + wc * 32 + 8 * fq;
#pragma unroll
        for (int ai = 0; ai < 2; ++ai)
#pragma unroll
            for (int m = 0; m < 4; ++m) { bf16* rowp = O + (size_t)(row0 + ai * HALF + m * 16) * ldc + col0;
#pragma unroll
                for (int bj = 0; bj < 2; ++bj) { const f32x4 v0 = acc[ai][bj][m][0], v1 = acc[ai][bj][m][1];
                    u32x4 w; w.x = cvt_pk(v0[0], v0[1]); w.y = cvt_pk(v0[2], v0[3]); w.z = cvt_pk(v1[0], v1[1]); w.w = cvt_pk(v1[2], v1[3]);
                    *(u32x4*)(rowp + bj * HALF) = w; } }
    }
};
template <bool ACCUM> struct EpiGate {
    bf16* O; int ldc; const bf16* gate; int ldg;
    __device__ __forceinline__ void operator()(const Acc& acc, const Unit& u, int wr, int wc, int fr, int fq) const {
        const int row0 = u.pm * BM + wr * 64 + fr, col0 = u.pn * BM + wc * 32 + 8 * fq;
#pragma unroll
        for (int ai = 0; ai < 2; ++ai)
#pragma unroll
            for (int m = 0; m < 4; ++m) { const size_t row = (size_t)(row0 + ai * HALF + m * 16);
#pragma unroll
                for (int bj = 0; bj < 2; ++bj) {
                    const u32x4 g = *(const u32x4*)(gate + row * ldg + col0 + bj * HALF);
                    const f32x4 v0 = acc[ai][bj][m][0], v1 = acc[ai][bj][m][1];
                    float r[8];
                    r[0] = v0[0] * fast_sigmoid(bf_lo(g.x)); r[1] = v0[1] * fast_sigmoid(bf_hi(g.x)); r[2] = v0[2] * fast_sigmoid(bf_lo(g.y)); r[3] = v0[3] * fast_sigmoid(bf_hi(g.y));
                    r[4] = v1[0] * fast_sigmoid(bf_lo(g.z)); r[5] = v1[1] * fast_sigmoid(bf_hi(g.z)); r[6] = v1[2] * fast_sigmoid(bf_lo(g.w)); r[7] = v1[3] * fast_sigmoid(bf_hi(g.w));
                    bf16* op = O + row * ldc + col0 + bj * HALF;
                    if (ACCUM) { const u32x4 o = *(const u32x4*)op;
                        r[0] += bf_lo(o.x); r[1] += bf_hi(o.x); r[2] += bf_lo(o.y); r[3] += bf_hi(o.y); r[4] += bf_lo(o.z); r[5] += bf_hi(o.z); r[6] += bf_lo(o.w); r[7] += bf_hi(o.w); }
                    u32x4 w; w.x = cvt_pk(r[0], r[1]); w.y = cvt_pk(r[2], r[3]); w.z = cvt_pk(r[4], r[5]); w.w = cvt_pk(r[6], r[7]);
                    *(u32x4*)op = w; } }
    }
};
struct EpiRes {
    const float* base; float* out; const float* gt; int gt_ld;
    __device__ __forceinline__ void operator()(const Acc& acc, const Unit& u, int wr, int wc, int fr, int fq) const {
        const int row0 = u.pm * BM + wr * 64 + fr, col0 = u.pn * BM + wc * 32 + 8 * fq;
        const float* gp = gt + (size_t)((u.pm * BM) / SEQ) * gt_ld + col0;
        f32x4 gv[2][2];
#pragma unroll
        for (int bj = 0; bj < 2; ++bj)
#pragma unroll
            for (int n = 0; n < 2; ++n) gv[bj][n] = *(const f32x4*)(gp + bj * HALF + 4 * n);
#pragma unroll
        for (int ai = 0; ai < 2; ++ai)
#pragma unroll
            for (int m = 0; m < 4; ++m) { const size_t off = (size_t)(row0 + ai * HALF + m * 16) * DM + col0;
#pragma unroll
                for (int bj = 0; bj < 2; ++bj)
#pragma unroll
                    for (int n = 0; n < 2; ++n) { const f32x4 b = *(const f32x4*)(base + off + bj * HALF + 4 * n);
                        *(f32x4*)(out + off + bj * HALF + 4 * n) = b + gv[bj][n] * acc[ai][bj][m][n]; } }
    }
};
struct EpiSwiglu {
    bf16* O; int ldc;
    __device__ __forceinline__ void operator()(const Acc& acc, const Unit& u, int wr, int wc, int fr, int fq) const {
        const int row0 = u.pm * BM + wr * 64 + fr, col0 = u.pn * HALF + wc * 32 + 8 * fq;
#pragma unroll
        for (int ai = 0; ai < 2; ++ai)
#pragma unroll
            for (int m = 0; m < 4; ++m) { float r[8];
#pragma unroll
                for (int n = 0; n < 2; ++n)
#pragma unroll
                    for (int e = 0; e < 4; ++e) { const float g = acc[ai][0][m][n][e], up = acc[ai][1][m][n][e]; r[4 * n + e] = g * fast_sigmoid(g) * up; }
                u32x4 w; w.x = cvt_pk(r[0], r[1]); w.y = cvt_pk(r[2], r[3]); w.z = cvt_pk(r[4], r[5]); w.w = cvt_pk(r[6], r[7]);
                *(u32x4*)(O + (size_t)(row0 + ai * HALF + m * 16) * ldc + col0) = w; }
    }
};

template <class Epi>
__device__ __forceinline__ void gemm_phase(LAS unsigned char* lds, const Gemm g, const StaticOrder& S, const Epi& E) {
    int tid = threadIdx.x;
    asm volatile("" : "+v"(tid));
    const int wid = __builtin_amdgcn_readfirstlane(tid >> 6), lane = tid & 63, wr = wid >> 2, wc = wid & 3, fr = lane & 15, fq = lane >> 4;
    const int K = g.K, nt = K / BK;
    unsigned voffA[2], voffB[2];
#pragma unroll
    for (int i = 0; i < 2; ++i) { int R, C; stage_rc(tid * 16 + i * 8192, R, C); const int Rb = (R & ~31) + perm32(R & 31);
        voffA[i] = (unsigned)(R * g.lda + C) * 2u; voffB[i] = (unsigned)(Rb * g.ldb + C) * 2u; }
    const size_t kstep = (size_t)(BK * 2);
    const size_t hstepA = (size_t)HALF * g.lda * 2, hstepB = (size_t)HALF * g.ldb * 2;
    const size_t tstepA = 2 * hstepA, tstepB = 2 * hstepB;
    const unsigned ldsw = (unsigned)wid * 1024u;
    const int aoff = lds_byte(wr * 64 + fr, fq * 8), boff = lds_byte(wc * 32 + fr, fq * 8);
#define PG8_SA(b, h) (((b) * 2 + (h)) * HTB)
#define PG8_SB(b, h) ((4 + (b) * 2 + (h)) * HTB)
#define PG8_STAGE(bufoff, gbase, voff) do { _Pragma("unroll") for (int _i = 0; _i < 2; ++_i) \
        __builtin_amdgcn_global_load_lds((const unsigned*)((const char*)(gbase) + (voff)[_i]), (LAS unsigned*)(lds + (bufoff) + ldsw + _i * 8192), 16, 0, 0); } while (0)
#define PG8_LDA(dst, b, h) do { _Pragma("unroll") for (int m = 0; m < 4; ++m) _Pragma("unroll") for (int k = 0; k < 2; ++k) dst[m][k] = *(const LAS bf16x8*)(lds + PG8_SA(b, h) + aoff + m * 2048 + k * 1024); } while (0)
#define PG8_LDB(dst, b, h) do { _Pragma("unroll") for (int n = 0; n < 2; ++n) _Pragma("unroll") for (int k = 0; k < 2; ++k) dst[n][k] = *(const LAS bf16x8*)(lds + PG8_SB(b, h) + boff + n * 2048 + k * 1024); } while (0)
#define PG8_MMA(ai, bj, At, Bt) do { __builtin_amdgcn_s_setprio(1); _Pragma("unroll") for (int m = 0; m < 4; ++m) _Pragma("unroll") for (int n = 0; n < 2; ++n) _Pragma("unroll") for (int k = 0; k < 2; ++k) \
        acc[ai][bj][m][n] = __builtin_amdgcn_mfma_f32_16x16x32_bf16(Bt[n][k], At[m][k], acc[ai][bj][m][n], 0, 0, 0); __builtin_amdgcn_s_setprio(0); } while (0)
#define PG8_WAIT_V(n) asm volatile("s_waitcnt vmcnt(" #n ")" ::: "memory")
#define PG8_WAIT_L(n) asm volatile("s_waitcnt lgkmcnt(" #n ")" ::: "memory")
#define PG8_BAR __builtin_amdgcn_s_barrier()
#define PG8_SCHED __builtin_amdgcn_sched_barrier(0)
    Unit cur, nxt; int ui = 0;
    if (!S.next(0, cur)) return;
    Acc acc;
#pragma unroll
    for (int a = 0; a < 2; ++a)
#pragma unroll
        for (int b = 0; b < 2; ++b)
#pragma unroll
            for (int m = 0; m < 4; ++m)
#pragma unroll
                for (int n = 0; n < 2; ++n) acc[a][b][m][n] = (f32x4){0.f, 0.f, 0.f, 0.f};
    bf16x8 At[4][2], B0[2][2], B1[2][2];
    const char* cA = (const char*)g.A + (size_t)cur.pm * tstepA; const char* cB = (const char*)g.Bt + (size_t)cur.pn * tstepB;
    PG8_STAGE(PG8_SB(0, 0), cB, voffB); PG8_STAGE(PG8_SB(0, 1), cB + hstepB, voffB); PG8_STAGE(PG8_SA(0, 0), cA, voffA); PG8_STAGE(PG8_SA(0, 1), cA + hstepA, voffA);
    if (wr == 1) PG8_BAR;
    PG8_WAIT_V(2); PG8_BAR;
    PG8_STAGE(PG8_SB(1, 0), cB + kstep, voffB); PG8_STAGE(PG8_SA(1, 0), cA + kstep, voffA); PG8_STAGE(PG8_SB(1, 1), cB + hstepB + kstep, voffB);
    PG8_WAIT_V(6); PG8_BAR;
    for (;;) {
        const bool has_next = S.next(ui + 1, nxt);
        const char* nA = has_next ? (const char*)g.A + (size_t)nxt.pm * tstepA : cA; const char* nB = has_next ? (const char*)g.Bt + (size_t)nxt.pn * tstepB : cB;
        for (int t = 0; t < nt; t += 2) {
            const bool last = (t == nt - 2);
            const char* a1 = cA + (size_t)(t + 1) * kstep;
            const char* a2 = last ? nA : cA + (size_t)(t + 2) * kstep; const char* b2 = last ? nB : cB + (size_t)(t + 2) * kstep;
            const char* a3 = a2 + kstep; const char* b3 = b2 + kstep;
            PG8_LDB(B0, 0, 0); PG8_LDB(B1, 0, 1); PG8_SCHED; PG8_LDA(At, 0, 0); PG8_STAGE(PG8_SA(1, 1), a1 + hstepA, voffA);
            PG8_WAIT_V(8); PG8_WAIT_L(0); PG8_BAR; PG8_MMA(0, 0, At, B0); PG8_MMA(0, 1, At, B1); PG8_BAR; PG8_SCHED;
            PG8_LDA(At, 0, 1); PG8_STAGE(PG8_SB(0, 0), b2, voffB); PG8_STAGE(PG8_SB(0, 1), b2 + hstepB, voffB); PG8_STAGE(PG8_SA(0, 0), a2, voffA);
            PG8_WAIT_V(8); PG8_WAIT_L(0); PG8_BAR; PG8_MMA(1, 0, At, B0); PG8_MMA(1, 1, At, B1); PG8_BAR; PG8_SCHED;
            PG8_LDB(B0, 1, 0); PG8_LDB(B1, 1, 1); PG8_SCHED; PG8_LDA(At, 1, 0); PG8_STAGE(PG8_SA(0, 1), a2 + hstepA, voffA);
            PG8_WAIT_V(8); PG8_WAIT_L(0); PG8_BAR; PG8_MMA(0, 0, At, B0); PG8_MMA(0, 1, At, B1); PG8_BAR; PG8_SCHED;
            PG8_LDA(At, 1, 1); PG8_STAGE(PG8_SB(1, 0), b3, voffB); PG8_STAGE(PG8_SB(1, 1), b3 + hstepB, voffB); PG8_STAGE(PG8_SA(1, 0), a3, voffA);
            PG8_WAIT_V(8); PG8_WAIT_L(0); PG8_BAR; PG8_MMA(1, 0, At, B0); PG8_MMA(1, 1, At, B1); PG8_BAR; PG8_SCHED;
        }
        if (wr == 0) PG8_BAR;
        E(acc, cur, wr, wc, fr, fq);
        if (!has_next) break;
#pragma unroll
        for (int a = 0; a < 2; ++a)
#pragma unroll
            for (int b = 0; b < 2; ++b)
#pragma unroll
                for (int m = 0; m < 4; ++m)
#pragma unroll
                    for (int n = 0; n < 2; ++n) acc[a][b][m][n] = (f32x4){0.f, 0.f, 0.f, 0.f};
        cur = nxt; cA = nA; cB = nB; ++ui;
        if (wr == 1) PG8_BAR;
    }
    PG8_WAIT_V(0);
    PG8_BAR;
#undef PG8_SA
#undef PG8_SB
#undef PG8_STAGE
#undef PG8_LDA
#undef PG8_LDB
#undef PG8_MMA
#undef PG8_WAIT_V
#undef PG8_WAIT_L
#undef PG8_BAR
#undef PG8_SCHED
}
}

__device__ __forceinline__ int crow(int r, int hi) { return (r & 3) + 8 * (r >> 2) + 4 * hi; }
__device__ __forceinline__ s16x4 vtr(const LAS unsigned char* p) { typedef short v4i16_t __attribute__((ext_vector_type(4)));
    return __builtin_bit_cast(s16x4, __builtin_amdgcn_ds_read_tr16_b64_v4i16((LAS v4i16_t*)p)); }
constexpr int AT_K0 = 0, AT_K1 = 25600, AT_V0 = 51200, AT_VBUF = 20480, AT_VROW = 320, AT_CNT = AT_V0 + 3 * AT_VBUF;

template <bool SBK>
__device__ __forceinline__ void attn_unit(LAS unsigned char* lds, const bf16* __restrict__ Qp, int ldq, const bf16* __restrict__ Kp, int ldk,
                                          const bf16* __restrict__ Vp, int ldv, bf16* __restrict__ Op, int ldo, int q0, int tid, int wave, int lane) {
    constexpr int DK = SBK ? 128 : 192, NST = DK / 16, KROW = DK * 2 + 16, KCH = DK / 8, NKI = (64 * KCH) / 512;
    asm volatile("" : "+v"(tid), "+v"(lane));
    const int ql = lane & 31, hi = lane >> 5, qw0 = q0 + 32 * wave, myq = qw0 + ql;
    const int nt = (q0 + 256) / 64;
    bf16x8 qf[NST];
    { const bf16* qrow = Qp + (size_t)myq * ldq + 8 * hi;
#pragma unroll
      for (int st = 0; st < NST; ++st) qf[st] = *(const bf16x8*)(qrow + 16 * st); }
    unsigned kgo[NKI], kls[NKI], vgo[2], vls[2];
#pragma unroll
    for (int i = 0; i < NKI; ++i) { const int c = tid + 512 * i, row = c / KCH, cc = c % KCH; kgo[i] = (unsigned)(row * ldk + cc * 8); kls[i] = (unsigned)(row * KROW + cc * 16); }
#pragma unroll
    for (int i = 0; i < 2; ++i) { const int c = tid + 512 * i, row = c >> 4, cc = c & 15; vgo[i] = (unsigned)(row * ldv + cc * 8); vls[i] = (unsigned)(row * AT_VROW + cc * 16); }
    u32x4 kr[NKI], vr[2];
#define AT_LOAD(j) do { const bf16* kp_ = Kp + (size_t)(64 * (j)) * ldk; const bf16* vp_ = Vp + (size_t)(64 * (j)) * ldv; \
        _Pragma("unroll") for (int i = 0; i < NKI; ++i) kr[i] = *(const u32x4*)(kp_ + kgo[i]); \
        _Pragma("unroll") for (int i = 0; i < 2; ++i) vr[i] = *(const u32x4*)(vp_ + vgo[i]); } while (0)
#define AT_STORE(jt) do { LAS unsigned char* kb_ = lds + (((jt) & 1) ? AT_K1 : AT_K0); LAS unsigned char* vb_ = lds + AT_V0 + (SBK ? ((jt) % 3) : ((jt) & 1)) * AT_VBUF; \
        _Pragma("unroll") for (int i = 0; i < NKI; ++i) *(LAS u32x4*)(kb_ + kls[i]) = kr[i]; \
        _Pragma("unroll") for (int i = 0; i < 2; ++i) *(LAS u32x4*)(vb_ + vls[i]) = vr[i]; } while (0)
    f32x16 o[4];
#pragma unroll
    for (int d = 0; d < 4; ++d)
#pragma unroll
        for (int i = 0; i < 16; ++i) o[d][i] = 0.f;
    float m_run = -INFINITY, l_run = 0.f, carry = 1.0f;
    const float qk_scale = SBK ? 0.08838834764831845f : 0.07216878364870323f;
    const float c2 = qk_scale * 1.4426950408889634f;
    const unsigned koff = (unsigned)(ql * KROW + hi * 16);
    const unsigned voff = (unsigned)((4 * hi + ((lane >> 2) & 3)) * AT_VROW + (16 * ((lane >> 4) & 1) + 4 * (lane & 3)) * 2);

    const bool grpB = SBK && wave >= 4; bool pend = false; int jpend = 0;
    unsigned pk[16];
#define AT_PV(jt) do { const LAS unsigned char* vb = lds + AT_V0 + (SBK ? ((jt) % 3) : ((jt) & 1)) * AT_VBUF + voff; \
        _Pragma("unroll") for (int dt = 0; dt < 4; ++dt) { __builtin_amdgcn_sched_barrier(0); \
            _Pragma("unroll") for (int ks = 0; ks < 4; ++ks) { \
                const s16x4 lo = vtr(vb + (16 * ks) * AT_VROW + dt * 64), h4 = vtr(vb + (16 * ks + 8) * AT_VROW + dt * 64); \
                const bf16x8 A = (bf16x8){lo[0], lo[1], lo[2], lo[3], h4[0], h4[1], h4[2], h4[3]}; \
                const u32x4 pw = (u32x4){pk[4 * ks], pk[4 * ks + 1], pk[4 * ks + 2], pk[4 * ks + 3]}; \
                o[dt] = __builtin_amdgcn_mfma_f32_32x32x16_bf16(A, __builtin_bit_cast(bf16x8, pw), o[dt], 0, 0, 0); } } } while (0)
    LAS unsigned* dcnt = (LAS unsigned*)(lds + AT_CNT);
    bool wdone = false;
    if (SBK && tid == 0) { dcnt[0] = 0u; dcnt[1] = 0u; dcnt[2] = 0u; }
    __syncthreads();
    { const int j0 = SBK ? nt - 1 : 0; AT_LOAD(j0); AT_STORE(0); }
    __syncthreads();
#pragma unroll 1
    for (int jj = 0; jj < nt; ++jj) {
        const int j = SBK ? nt - 1 - jj : jj, k0 = 64 * j, b = jj & 1;
        const bool more = (jj + 1 < nt);
        if (more) { const int jn = SBK ? j - 1 : j + 1; AT_LOAD(jn); }
        if (pend) { AT_PV(jpend); pend = false; }
        const bool active = SBK ? (k0 < qw0 + 31 && !wdone) : (k0 <= qw0 + 31);
        if (active) {
            const LAS unsigned char* kb = lds + (b ? AT_K1 : AT_K0) + koff;
            f32x16 s0, s1;
#pragma unroll
            for (int i = 0; i < 16; ++i) { s0[i] = 0.f; s1[i] = 0.f; }
#pragma unroll
            for (int st = 0; st < NST; ++st) {
                const bf16x8 a0 = *(const LAS bf16x8*)(kb + st * 32), a1 = *(const LAS bf16x8*)(kb + 32 * KROW + st * 32);
                s0 = __builtin_amdgcn_mfma_f32_32x32x16_bf16(a0, qf[st], s0, 0, 0, 0);
                s1 = __builtin_amdgcn_mfma_f32_32x32x16_bf16(a1, qf[st], s1, 0, 0, 0);
                if ((st & 3) == 3) __builtin_amdgcn_sched_barrier(0);
            }
            if (!SBK) {
                const bool need_mask = (k0 + 63 > qw0);
                if (need_mask) {
#pragma unroll
                    for (int i = 0; i < 16; ++i) { const int key = k0 + crow(i, hi); if (key > myq) s0[i] = -INFINITY; if (key + 32 > myq) s1[i] = -INFINITY; }
                }
                float mx = s0[0];
#pragma unroll
                for (int i = 1; i < 16; ++i) mx = fmaxf(mx, s0[i]);
#pragma unroll
                for (int i = 0; i < 16; ++i) mx = fmaxf(mx, s1[i]);
                mx = fmaxf(mx, xhalf(mx));
                if (!__all((mx - m_run) * c2 <= 8.0f)) {
                    asm volatile("" ::: "memory");
                    const float m_new = fmaxf(m_run, mx);
                    const float alpha = __builtin_amdgcn_exp2f((m_run - m_new) * c2);
                    m_run = m_new; l_run *= alpha;
#pragma unroll
                    for (int d = 0; d < 4; ++d)
#pragma unroll
                        for (int i = 0; i < 16; ++i) o[d][i] *= alpha;
                }
                const float mc = m_run * c2;
                float ls = 0.f;
#pragma unroll
                for (int i = 0; i < 16; ++i) { s0[i] = __builtin_amdgcn_exp2f(s0[i] * c2 - mc); ls += s0[i]; }
#pragma unroll
                for (int i = 0; i < 16; ++i) { s1[i] = __builtin_amdgcn_exp2f(s1[i] * c2 - mc); ls += s1[i]; }
                l_run += ls;
            } else {
                const bool need_mask = (k0 + 63 >= qw0);
                float omv[32], own[8], par[8];
                const float nsl2 = -qk_scale * 1.4426950408889634f;
#pragma unroll
                for (int sub = 0; sub < 2; ++sub)
#pragma unroll
                    for (int i = 0; i < 16; ++i) {
                        const float z2 = fminf((sub ? s1[i] : s0[i]) * nsl2, 120.0f);
                        const float ex = __builtin_amdgcn_exp2f(z2);
                        float bt = __builtin_amdgcn_rcpf(1.0f + ex);
                        float om = ex * bt;
                        if (need_mask) { const int key = k0 + 32 * sub + crow(i, hi); if (key >= myq) { bt = 0.f; om = 1.0f; } }
                        omv[16 * sub + i] = om;
                        if (sub) s1[i] = bt; else s0[i] = bt;
                    }
#pragma unroll
                for (int m = 0; m < 8; ++m) { own[m] = (omv[4 * m] * omv[4 * m + 1]) * (omv[4 * m + 2] * omv[4 * m + 3]); par[m] = xhalf(own[m]); }
                float Tm = 1.0f;
#pragma unroll
                for (int m = 7; m >= 0; --m) {
                    float run = Tm * carry * (hi == 0 ? par[m] : 1.0f);
#pragma unroll
                    for (int r = 3; r >= 0; --r) {
                        const int idx = 4 * m + r;
                        if (idx >= 16) s1[idx - 16] *= run; else s0[idx] *= run;
                        run *= omv[idx];
                    }
                    Tm *= own[m] * par[m];
                }
                carry *= Tm;
            }
#pragma unroll
            for (int js = 0; js < 2; ++js)
#pragma unroll
                for (int w = 0; w < 4; ++w) { pk[4 * js + w] = cvt_pk(s0[8 * js + 2 * w], s0[8 * js + 2 * w + 1]); pk[8 + 4 * js + w] = cvt_pk(s1[8 * js + 2 * w], s1[8 * js + 2 * w + 1]); }
            if (grpB) { pend = true; jpend = jj; } else AT_PV(jj);
        }
        if (SBK) {
            if (!wdone && k0 < qw0 + 31) wdone = __all(carry < 1e-37f);
            if (wdone && lane == 0) __hip_atomic_fetch_add(dcnt + (jj % 3), 1u, __ATOMIC_RELAXED, __HIP_MEMORY_SCOPE_WORKGROUP);
        }
        if (more) AT_STORE(jj + 1);
        __syncthreads();
        if (SBK) {
            if (tid == 0) dcnt[(jj + 2) % 3] = 0u;
            if (dcnt[jj % 3] == 8u) break;
        }
    }
    if (pend) { AT_PV(jpend); pend = false; }
#undef AT_LOAD
#undef AT_STORE
#undef AT_PV
    float inv = 1.0f;
    if (!SBK) { const float lt = l_run + xhalf(l_run); inv = 1.0f / lt; }
    bf16* orow = Op + (size_t)myq * ldo + 4 * hi;
#pragma unroll
    for (int dt = 0; dt < 4; ++dt)
#pragma unroll
        for (int gi = 0; gi < 4; ++gi) {
            u32x2 w; w.x = cvt_pk(o[dt][4 * gi] * inv, o[dt][4 * gi + 1] * inv); w.y = cvt_pk(o[dt][4 * gi + 2] * inv, o[dt][4 * gi + 3] * inv);
            *(u32x2*)(orow + 32 * dt + 8 * gi) = w;
        }
}

struct Args {
    const float *x, *c; const int* pos; const float *w_ada, *b_ada, *g1, *g2, *w_in, *g_ql, *g_kvl, *w_uq, *w_ukv, *g_qh, *g_kh, *w_pa, *w_pb, *w_out, *w_fi, *w_fo;
    float* out; unsigned char* ws;
};

__device__ __forceinline__ void transpose_item(const float* __restrict__ W, int K, int N, bf16* __restrict__ WT, int k0, int n0, int dest_row0, const float* __restrict__ kgain, LAS float* scr, int lane) {
    float tv[32];
#pragma unroll
    for (int i = 0; i < 32; ++i) tv[i] = W[(size_t)(k0 + 2 * i + (lane >> 5)) * N + n0 + (lane & 31)];
    if (kgain) {
#pragma unroll
        for (int i = 0; i < 32; ++i) tv[i] *= kgain[k0 + 2 * i + (lane >> 5)];
    }
#pragma unroll
    for (int i = 0; i < 32; ++i) scr[(2 * i + (lane >> 5)) * 33 + (lane & 31)] = tv[i];
    asm volatile("s_waitcnt lgkmcnt(0)" ::: "memory");
    const int c = lane & 7;
#pragma unroll
    for (int j = 0; j < 4; ++j) { const int n = (lane >> 3) + 8 * j; const LAS float* s = scr + (8 * c) * 33 + n;
        u32x4 o; o.x = cvt_pk(s[0 * 33], s[1 * 33]); o.y = cvt_pk(s[2 * 33], s[3 * 33]); o.z = cvt_pk(s[4 * 33], s[5 * 33]); o.w = cvt_pk(s[6 * 33], s[7 * 33]);
        *(u32x4*)(WT + (size_t)(dest_row0 + n) * K + k0 + 8 * c) = o; }
    asm volatile("s_waitcnt lgkmcnt(0)" ::: "memory");
}

constexpr int CI_IN = (DM / 64) * (DIN / 32), CI_UQ = (512 / 64) * (1536 / 32), CI_UKV = (512 / 64) * (2048 / 32), CI_P = (1024 / 64) * (DM / 32), CI_OUT = (DM / 64) * (DM / 32),
              CI_FI = (DM / 64) * (2 * DFF / 32), CI_FO = (DFF / 64) * (DM / 32);
constexpr int CI_FI_P3 = 2048;
constexpr int CI_EARLY = CI_IN + CI_UQ + CI_UKV, CI_LATEA = CI_FO + CI_OUT + 2 * CI_P, CI_ALL = CI_EARLY + CI_LATEA + CI_FI;
__device__ __forceinline__ void convert_item(const Args& a, int it, LAS float* scr, int lane) {
    unsigned char* ws = a.ws;
    int r = it;
    if (r < CI_IN) { const int nblk = DIN / 32, kb = r / nblk, nb = r % nblk; const int n0 = 32 * nb; const int dest = n0 < 1088 ? n0 : n0 + 192;
        transpose_item(a.w_in, DM, DIN, (bf16*)(ws + WS_WIN), 64 * kb, n0, dest, nullptr, scr, lane); return; } r -= CI_IN;
    if (r < CI_UQ) { const int nblk = 1536 / 32, kb = r / nblk, nb = r % nblk; transpose_item(a.w_uq, 512, 1536, (bf16*)(ws + WS_WUQ), 64 * kb, 32 * nb, 32 * nb, a.g_ql, scr, lane); return; } r -= CI_UQ;
    if (r < CI_UKV) { const int nblk = 2048 / 32, kb = r / nblk, nb = r % nblk; transpose_item(a.w_ukv, 512, 2048, (bf16*)(ws + WS_WUKV), 64 * kb, 32 * nb, 32 * nb, a.g_kvl, scr, lane); return; } r -= CI_UKV;
    if (r < CI_FO) { const int nblk = DM / 32, kb = r / nblk, nb = r % nblk; transpose_item(a.w_fo, DFF, DM, (bf16*)(ws + WS_WFO), 64 * kb, 32 * nb, 32 * nb, nullptr, scr, lane); return; } r -= CI_FO;
    if (r < CI_OUT) { const int nblk = DM / 32, kb = r / nblk, nb = r % nblk; transpose_item(a.w_out, DM, DM, (bf16*)(ws + WS_WOUT), 64 * kb, 32 * nb, 32 * nb, nullptr, scr, lane); return; } r -= CI_OUT;
    if (r < CI_P) { const int nblk = DM / 32, kb = r / nblk, nb = r % nblk; transpose_item(a.w_pa, 1024, DM, (bf16*)(ws + WS_WPA), 64 * kb, 32 * nb, 32 * nb, nullptr, scr, lane); return; } r -= CI_P;
    if (r < CI_P) { const int nblk = DM / 32, kb = r / nblk, nb = r % nblk; transpose_item(a.w_pb, 1024, DM, (bf16*)(ws + WS_WPB), 64 * kb, 32 * nb, 32 * nb, nullptr, scr, lane); return; } r -= CI_P;
    { const int nblk = 2 * DFF / 32, kb = r / nblk, nb = r % nblk; const int n0 = 32 * nb; const int jn = n0 < DFF ? n0 : n0 - DFF;
      const int dest = 256 * (jn / 128) + (jn % 128) + (n0 < DFF ? 0 : 128);
      transpose_item(a.w_fi, DM, 2 * DFF, (bf16*)(ws + WS_WFI), 64 * kb, n0, dest, nullptr, scr, lane); }
}

__device__ __forceinline__ void p0_prologue(const Args& a, LAS unsigned char* lds, int gw, int NGW, int wave, int lane) {
    unsigned char* ws = a.ws;
    float* part = (float*)(ws + WS_Y);
    for (int it = gw; it < 48 * NPART; it += NGW) {
        const int cgp = it % 48, kc = it / 48;
        float sv[4];
#pragma unroll
        for (int b = 0; b < 4; ++b) { const float cv = a.c[b * DM + kc * 64 + lane]; sv[b] = cv * fast_sigmoid(cv); }
        f32x4 acc[4];
#pragma unroll
        for (int b = 0; b < 4; ++b) acc[b] = (f32x4){0.f, 0.f, 0.f, 0.f};
        const float* wp = a.w_ada + (size_t)(kc * 64) * ADA_N + cgp * 256 + lane * 4;
#pragma unroll 8
        for (int kk = 0; kk < 64; ++kk) {
            const f32x4 w = *(const f32x4*)(wp + (size_t)kk * ADA_N);
#pragma unroll
            for (int b = 0; b < 4; ++b) { const float s = __uint_as_float(__builtin_amdgcn_readlane(__float_as_uint(sv[b]), kk)); acc[b] += w * s; }
        }
#pragma unroll
        for (int b = 0; b < 4; ++b) *(f32x4*)(part + (size_t)(kc * 4 + b) * ADA_N + cgp * 256 + lane * 4) = acc[b];
    }
    LAS float* scr = (LAS float*)(lds + wave * 8704);
    for (int it = gw; it < CI_EARLY + CI_FI - CI_FI_P3; it += NGW) convert_item(a, it < CI_EARLY ? it : it + CI_LATEA, scr, lane);
    bf16* Win = (bf16*)(a.ws + WS_WIN);
    for (int p = gw * 64 + lane; p < 192 * DM / 8; p += NGW * 64) *(u32x4*)(Win + (size_t)1088 * DM + (size_t)p * 8) = (u32x4){0u, 0u, 0u, 0u};
}

__device__ __forceinline__ void norm_rows(const float* __restrict__ src, bf16* __restrict__ dst, const LAS float* scale, const LAS float* shift, int row0, int wave, int lane) {
#pragma unroll 1
    for (int r = 0; r < 8; ++r) {
        const int row = row0 + wave * 8 + r;
        const f32x4* xr = (const f32x4*)(src + (size_t)row * DM) + lane;
        f32x4 v[8]; float ss = 0.f;
#pragma unroll
        for (int j = 0; j < 8; ++j) { v[j] = xr[64 * j]; ss += (v[j].x * v[j].x + v[j].y * v[j].y) + (v[j].z * v[j].z + v[j].w * v[j].w); }
        const float rstd = 1.0f / sqrtf(wave_sum(ss) * (1.0f / DM) + EPS);
        u32x2* orow = (u32x2*)(dst + (size_t)row * DM) + lane;
#pragma unroll
        for (int j = 0; j < 8; ++j) { const int col = 4 * (64 * j + lane); const f32x4 sc = *(const LAS f32x4*)(scale + col), sh = *(const LAS f32x4*)(shift + col);
            const f32x4 y = v[j] * rstd * sc + sh; u32x2 w; w.x = cvt_pk(y.x, y.y); w.y = cvt_pk(y.z, y.w); orow[64 * j] = w; }
    }
}

#define XB_TMO      128
#define XB_XCNT(j)  (256  + 64 * (j))
#define XB_XSUB(j)  (1280 + 64 * (j))
#define XB_XGEN(j)  (2304 + 64 * (j))
#define XB_TOP      3328
#define XB_TOPGEN   3392
#define XCD_BAR_WORDS 3456
#define XB_SPIN_CAP (1u << 20)
__device__ __forceinline__ unsigned xb_ld(unsigned* p)              { return __hip_atomic_load(p, __ATOMIC_RELAXED, __HIP_MEMORY_SCOPE_AGENT); }
__device__ __forceinline__ unsigned xb_add(unsigned* p, unsigned v) { return __hip_atomic_fetch_add(p, v, __ATOMIC_RELAXED, __HIP_MEMORY_SCOPE_AGENT); }
__device__ __forceinline__ unsigned xb_xcc_id() { return (unsigned)__builtin_amdgcn_s_getreg((3 << 11) | 20) & 0xFu; }
#define XB_SPIN(cond, bar) do { unsigned _sp = 0; while (cond) { __builtin_amdgcn_s_sleep(1); \
    if ((++_sp & 255u) == 0u) { if (xb_ld(&(bar)[XB_TMO])) break; if (_sp > XB_SPIN_CAP) { atomicAdd(&(bar)[XB_TMO], 1u); break; } } } } while (0)
struct XcdBarrier { unsigned* bar; unsigned x; volatile LAS unsigned* st; };
__device__ __forceinline__ XcdBarrier xcd_barrier_post(unsigned* bar, volatile LAS unsigned* st) {
    XcdBarrier b; b.bar = bar; b.x = xb_xcc_id(); b.st = st;
    if (threadIdx.x == 0) st[3] = xb_add(&bar[XB_XCNT(b.x)], 1u);
    return b;
}
__device__ __forceinline__ void xcd_barrier_complete(unsigned* bar, unsigned x, unsigned& nloc, unsigned& nx, unsigned& even32) {
    const unsigned G = gridDim.x * gridDim.y * gridDim.z;
    unsigned sum, cnt, mine, sp = 0u;
    for (;;) {
        sum = 0u; cnt = 0u; mine = 0u; even32 = 1u;
#pragma unroll
        for (unsigned j = 0; j < 16; ++j) { const unsigned c = xb_ld(&bar[XB_XCNT(j)]); sum += c; cnt += (c > 0u) ? 1u : 0u; mine = (j == x) ? c : mine; if (c != 0u && c != 32u) even32 = 0u; }
        if (sum == G) break;
        __builtin_amdgcn_s_sleep(1);
        if ((++sp & 255u) == 0u) { if (xb_ld(&bar[XB_TMO])) break; if (sp > XB_SPIN_CAP) { atomicAdd(&bar[XB_TMO], 1u); break; } }
    }
    nloc = mine > 0u ? mine : 1u; nx = cnt > 0u ? cnt : 1u;
}
__device__ __forceinline__ void xcd_barrier(const XcdBarrier& b) {
    asm volatile("s_waitcnt vmcnt(0)" ::: "memory");
    __syncthreads();
    if (threadIdx.x == 0) {
        unsigned* bar = b.bar;
        __builtin_amdgcn_s_waitcnt(0);
        unsigned nloc = b.st[0], nx = b.st[1];
        if (nloc == 0u) { unsigned e32; xcd_barrier_complete(bar, b.x, nloc, nx, e32); b.st[0] = nloc; b.st[1] = nx;
            b.st[2] = (e32 && nx == 8u && gridDim.x == 256u && !xb_ld(&bar[XB_TMO])) ? 1u : 0u; }
        const unsigned old = xb_add(&bar[XB_XSUB(b.x)], 1u);
        const unsigned gen = old / nloc;
        if (old + 1u == (gen + 1u) * nloc) {
            __builtin_amdgcn_fence(__ATOMIC_RELEASE, "agent");
            asm volatile("s_waitcnt vmcnt(0)" ::: "memory");
            const unsigned og = xb_add(&bar[XB_TOP], 1u);
            const unsigned tg = og / nx;
            if (og + 1u == (tg + 1u) * nx) xb_add(&bar[XB_TOPGEN], 1u);
            else XB_SPIN(xb_ld(&bar[XB_TOPGEN]) == tg, bar);
            __builtin_amdgcn_fence(__ATOMIC_ACQUIRE, "agent");
            xb_add(&bar[XB_XGEN(b.x)], 1u);
            asm volatile("s_waitcnt vmcnt(0)" ::: "memory");
        } else {
            XB_SPIN(xb_ld(&bar[XB_XGEN(b.x)]) == gen, bar);
            __builtin_amdgcn_fence(__ATOMIC_ACQUIRE, "agent");
            asm volatile("s_waitcnt vmcnt(0)" ::: "memory");
        }
    }
    __syncthreads();
}

#define XL_SUB(j) (4096 + 64 * (j))
#define XL_GEN(j) (5120 + 64 * (j))
__device__ __forceinline__ void xcc_local_barrier(const XcdBarrier& b) {
    asm volatile("s_waitcnt vmcnt(0)" ::: "memory");
    __syncthreads();
    if (threadIdx.x == 0) {
        unsigned* bar = b.bar;
        __builtin_amdgcn_s_waitcnt(0);
        const unsigned old = xb_add(&bar[XL_SUB(b.x)], 1u);
        const unsigned gen = old / 32u;
        if (old + 1u == (gen + 1u) * 32u) xb_add(&bar[XL_GEN(b.x)], 1u);
        else XB_SPIN(xb_ld(&bar[XL_GEN(b.x)]) == gen, bar);
        __builtin_amdgcn_fence(__ATOMIC_ACQUIRE, "agent");
        asm volatile("s_waitcnt vmcnt(0)" ::: "memory");
    }
    __syncthreads();
}

__global__ void __launch_bounds__(512, 2) fwd_megakernel(Args a) {
    extern __shared__ __attribute__((aligned(16))) unsigned char lds_raw[];
    LAS unsigned char* lds = (LAS unsigned char*)lds_raw;
    cg::grid_group grid = cg::this_grid();
    const int tid = threadIdx.x, lane = tid & 63, wave = __builtin_amdgcn_readfirstlane(tid >> 6);
    const int G = gridDim.x, bx = blockIdx.x;
    const int vcu = (G % 8 == 0) ? (bx % 8) * (G / 8) + bx / 8 : bx;
    const int gw = vcu * 8 + wave, NGW = G * 8;
    unsigned char* ws = a.ws;
    float* ada = (float*)(ws + WS_ADA);
    float* part = (float*)(ws + WS_Y);
    bf16* Win = (bf16*)(ws + WS_WIN); bf16* Wuq = (bf16*)(ws + WS_WUQ); bf16* Wukv = (bf16*)(ws + WS_WUKV); bf16* Wpa = (bf16*)(ws + WS_WPA); bf16* Wpb = (bf16*)(ws + WS_WPB);
    bf16* Wout = (bf16*)(ws + WS_WOUT); bf16* Wfi = (bf16*)(ws + WS_WFI); bf16* Wfo = (bf16*)(ws + WS_WFO);
    bf16* proj = (bf16*)(ws + WS_PROJ); bf16* act = (bf16*)(ws + WS_PROJ);
    bf16* kvraw = (bf16*)(ws + WS_KVRAW); bf16* merged = (bf16*)(ws + WS_KVRAW);
    bf16* ybuf = (bf16*)(ws + WS_Y); bf16* h2 = (bf16*)(ws + WS_Y);
    bf16* hbuf = (bf16*)a.out; bf16* qbuf = (bf16*)((unsigned char*)a.out + DO_Q); bf16* kbuf = (bf16*)a.out;
    LAS float* tscale = (LAS float*)lds; LAS float* tshift = (LAS float*)(lds + 8192);
    volatile LAS unsigned* bst = (volatile LAS unsigned*)(lds + LDS_MISC);
    if (tid == 0) { bst[0] = 0u; bst[1] = 0u; bst[2] = 0u; bst[3] = 0u; }
    __syncthreads();
    const XcdBarrier xbar = xcd_barrier_post(g_ctl, bst);
#define PROBE_SEL -1
#define PROBE_K 8
    int n_stamp = 0;
#define STAMP() do { if (PROBE_SEL >= 0) { if (tid == 0) ((volatile LAS unsigned long long*)(lds + LDS_MISC + 64))[n_stamp] = __builtin_amdgcn_s_memrealtime(); ++n_stamp; } } while (0)
#define GRID_BAR() do { xcd_barrier(xbar); STAMP(); } while (0)
#define LOCAL_BAR() do { if (local_ok) xcc_local_barrier(xbar); else xcd_barrier(xbar); STAMP(); } while (0)
    STAMP();

    p0_prologue(a, lds, gw, NGW, wave, lane);
    if (a.ws == nullptr) grid.sync();
    GRID_BAR();

    const bool local_ok = bst[2] != 0u;
    const int cidx = local_ok ? (int)(bst[3] * 8u + xbar.x) : bx;
    const int rowblk = local_ok ? (int)(xbar.x * 32u + bst[3]) : bx;
    for (int e = bx * 512 + tid; e < NB * ADA_N; e += G * 512) { const int b = e / ADA_N, n = e % ADA_N; float v = a.b_ada[n];
        for (int p = 0; p < NPART; ++p) v += part[(size_t)(p * 4 + b) * ADA_N + n];
        ada[e] = v; }
    for (int ch = rowblk; ch < T / 64; ch += G) {
        const int b = (ch * 64) / SEQ;
        __syncthreads();
        for (int d = tid; d < DM; d += 512) { float sh = a.b_ada[d], sc = a.b_ada[DM + d];
            for (int p = 0; p < NPART; ++p) { sh += part[(size_t)(p * 4 + b) * ADA_N + d]; sc += part[(size_t)(p * 4 + b) * ADA_N + DM + d]; }
            tscale[d] = a.g1[d] * (1.0f + sc); tshift[d] = sh; }
        __syncthreads();
        norm_rows(a.x, hbuf, tscale, tshift, ch * 64, wave, lane);
    }
    LOCAL_BAR();

    { pg8::Gemm g{hbuf, Win, T, PLD, DM, DM, DM}; pg8::StaticOrder S; S.init(T, PLD, G, cidx); pg8::EpiBf16 E{proj, PLD}; pg8::gemm_phase(lds, g, S, E);
      const int nun = (T / 256) * (PLD / 256), rem = nun % G, npart = rem ? G - rem : G, rank = rem ? cidx - rem : cidx;
      if (rank >= 0) { LAS float* scr = (LAS float*)(lds + wave * 8704);
          for (int it = rank * 8 + wave; it < CI_LATEA; it += npart * 8) convert_item(a, CI_EARLY + it, scr, lane); } }
    LOCAL_BAR();

    { pg8::Gemm g{proj, Wuq, T, 1536, 512, PLD, 512}; pg8::StaticOrder S; S.init(T, 1536, G, cidx); pg8::EpiBf16 E{qbuf, 1536}; pg8::gemm_phase(lds, g, S, E); }
    { pg8::Gemm g{proj + 512, Wukv, T, 2048, 512, PLD, 512}; pg8::StaticOrder S; S.init(T, 2048, G, cidx); pg8::EpiBf16 E{kvraw, 2048}; pg8::gemm_phase(lds, g, S, E); }
    {
      const int nq = (T / 256) * (1536 / 256), rem = nq % G, npart = rem ? G - rem : G, rank = rem ? cidx - rem : cidx;
      if (rank >= 0) { LAS float* scr = (LAS float*)(lds + wave * 8704);
          for (int it = rank * 8 + wave; it < CI_FI_P3; it += npart * 8) convert_item(a, CI_EARLY + CI_LATEA + CI_FI - CI_FI_P3 + it, scr, lane); } }
    LOCAL_BAR();

    { const int hd = lane >> 3, j = lane & 7;
      float gq[24], gk[24], fq_[8];
#pragma unroll
      for (int c = 0; c < 3; ++c)
#pragma unroll
          for (int e2 = 0; e2 < 8; ++e2) { gq[8 * c + e2] = a.g_qh[64 * c + 8 * j + e2]; gk[8 * c + e2] = a.g_kh[64 * c + 8 * j + e2]; }
#pragma unroll
      for (int e2 = 0; e2 < 8; ++e2) fq_[e2] = ROPE_FREQ[8 * (j & 3) + e2];
#define UNPK8(u, f) do { f[0] = bf_lo(u.x); f[1] = bf_hi(u.x); f[2] = bf_lo(u.y); f[3] = bf_hi(u.y); f[4] = bf_lo(u.z); f[5] = bf_hi(u.z); f[6] = bf_lo(u.w); f[7] = bf_hi(u.w); } while (0)
#define PK8(f) ((u32x4){cvt_pk(f[0], f[1]), cvt_pk(f[2], f[3]), cvt_pk(f[4], f[5]), cvt_pk(f[6], f[7])})
#pragma unroll 2
      for (int tk = 0; tk < (T + NGW - 1) / NGW; ++tk) { const int t = local_ok ? (rowblk * 8 + wave) * 8 + tk : gw + tk * NGW; if (t >= T) break;
        const bf16* prow = proj + (size_t)t * PLD;
        bf16* qrow = qbuf + (size_t)t * 1536 + hd * DQK + 8 * j; bf16* krow = kbuf + (size_t)t * 2048 + hd * DQK + 8 * j; bf16* kvrow = kvraw + (size_t)t * 2048 + hd * 256;
        const u32x4 ulq = *(const u32x4*)(prow + lane * 8), ulk = *(const u32x4*)(prow + 512 + lane * 8), upe = *(const u32x4*)(prow + C_KPE + 8 * j);
        const u32x4 uq0 = *(const u32x4*)(qrow), uq1 = *(const u32x4*)(qrow + 64), uq2 = *(const u32x4*)(qrow + 128);
        const u32x4 uk0 = *(const u32x4*)(kvrow + 8 * j), uk1 = *(const u32x4*)(kvrow + 64 + 8 * j);
        const u32x4 uv0 = *(const u32x4*)(kvrow + 128 + 16 * j), uv1 = *(const u32x4*)(kvrow + 136 + 16 * j);
        const float posf = (float)a.pos[t];
        float tf[8]; float aq, akv;
        { UNPK8(ulq, tf); float s2 = 0.f;
#pragma unroll
          for (int e2 = 0; e2 < 8; ++e2) s2 += tf[e2] * tf[e2];
          aq = 1.0f / sqrtf(wave_sum(s2) * (1.0f / 512.0f) + EPS); }
        { UNPK8(ulk, tf); float s2 = 0.f;
#pragma unroll
          for (int e2 = 0; e2 < 8; ++e2) s2 += tf[e2] * tf[e2];
          akv = 1.0f / sqrtf(wave_sum(s2) * (1.0f / 512.0f) + EPS); }
        float cs[8], sn[8];
#pragma unroll
        for (int e2 = 0; e2 < 8; ++e2) { const float ang = posf * fq_[e2]; double rev = (double)ang * 0.15915494309189535; rev -= __builtin_rint(rev);
            sn[e2] = __builtin_amdgcn_sinf((float)rev); cs[e2] = __builtin_amdgcn_cosf((float)rev); }
        { float x0[8], x1[8], x2[8]; UNPK8(uq0, x0); UNPK8(uq1, x1); UNPK8(uq2, x2); float s2 = 0.f;
#pragma unroll
          for (int e2 = 0; e2 < 8; ++e2) { x0[e2] *= aq; x1[e2] *= aq; x2[e2] *= aq; s2 += x0[e2] * x0[e2] + x1[e2] * x1[e2] + x2[e2] * x2[e2]; }
          s2 += __shfl_xor(s2, 1); s2 += __shfl_xor(s2, 2); s2 += __shfl_xor(s2, 4);
          const float rstd = 1.0f / sqrtf(s2 * (1.0f / DQK) + EPS);
#pragma unroll
          for (int e2 = 0; e2 < 8; ++e2) { x0[e2] *= rstd * gq[e2]; x1[e2] *= rstd * gq[8 + e2]; const float f2 = x2[e2] * rstd * gq[16 + e2], pf = __shfl_xor(f2, 4);
              x2[e2] = j < 4 ? f2 * cs[e2] - pf * sn[e2] : pf * sn[e2] + f2 * cs[e2]; }
          *(u32x4*)(qrow) = PK8(x0); *(u32x4*)(qrow + 64) = PK8(x1); *(u32x4*)(qrow + 128) = PK8(x2); }
        { float x0[8], x1[8], x2[8]; UNPK8(uk0, x0); UNPK8(uk1, x1); UNPK8(upe, x2); float s2 = 0.f;
#pragma unroll
          for (int e2 = 0; e2 < 8; ++e2) { x0[e2] *= akv; x1[e2] *= akv; s2 += x0[e2] * x0[e2] + x1[e2] * x1[e2] + x2[e2] * x2[e2]; }
          s2 += __shfl_xor(s2, 1); s2 += __shfl_xor(s2, 2); s2 += __shfl_xor(s2, 4);
          const float rstd = 1.0f / sqrtf(s2 * (1.0f / DQK) + EPS);
#pragma unroll
          for (int e2 = 0; e2 < 8; ++e2) { x0[e2] *= rstd * gk[e2]; x1[e2] *= rstd * gk[8 + e2]; const float f2 = x2[e2] * rstd * gk[16 + e2], pf = __shfl_xor(f2, 4);
              x2[e2] = j < 4 ? f2 * cs[e2] - pf * sn[e2] : pf * sn[e2] + f2 * cs[e2]; }
          *(u32x4*)(krow) = PK8(x0); *(u32x4*)(krow + 64) = PK8(x1); *(u32x4*)(krow + 128) = PK8(x2); }
        { float x0[8], x1[8]; UNPK8(uv0, x0); UNPK8(uv1, x1);
#pragma unroll
          for (int e2 = 0; e2 < 8; ++e2) { x0[e2] *= akv; x1[e2] *= akv; }
          *(u32x4*)(kvrow + 128 + 16 * j) = PK8(x0); *(u32x4*)(kvrow + 136 + 16 * j) = PK8(x1); }
      }
#undef UNPK8
#undef PK8
    }
    GRID_BAR();

    for (int su = vcu; su < 256; su += G) {
        const int bh = su >> 3, p = su & 7, b = bh >> 3, h = bh & 7;
        const size_t r0 = (size_t)b * SEQ;
#pragma unroll 1
        for (int half = 0; half < 2; ++half) { const int qb = half ? p : 15 - p;
            attn_unit<false>(lds, qbuf + r0 * 1536 + h * DQK, 1536, kbuf + r0 * 2048 + h * DQK, 2048, kvraw + r0 * 2048 + h * 256 + 128, 2048, ybuf + r0 * DM + h * 128, DM, qb * 256, tid, wave, lane);
        }
#pragma unroll 1
        for (int half = 0; half < 2; ++half) { const int qb = half ? p : 15 - p;
            attn_unit<true>(lds, proj + r0 * PLD + C_SBQ + h * 128, PLD, proj + r0 * PLD + C_SBK + h * 128, PLD, proj + r0 * PLD + C_SBV + h * 128, PLD, ybuf + r0 * DM + 1024 + h * 128, DM, qb * 256, tid, wave, lane);
        }
    }
    GRID_BAR();

    { pg8::Gemm g{ybuf, Wpa, T, DM, 1024, DM, 1024}; pg8::StaticOrder S; S.init(T, DM, G, cidx); pg8::EpiGate<false> E{merged, DM, proj + C_GA, PLD}; pg8::gemm_phase(lds, g, S, E); }
    { pg8::Gemm g{ybuf + 1024, Wpb, T, DM, 1024, DM, 1024}; pg8::StaticOrder S; S.init(T, DM, G, cidx); pg8::EpiGate<true> E{merged, DM, proj + C_GB, PLD}; pg8::gemm_phase(lds, g, S, E); }
    LOCAL_BAR();

    { pg8::Gemm g{merged, Wout, T, DM, DM, DM, DM}; pg8::StaticOrder S; S.init(T, DM, G, cidx); pg8::EpiRes E{a.x, a.out, ada + 2 * DM, ADA_N}; pg8::gemm_phase(lds, g, S, E); }
    LOCAL_BAR();

    for (int ch = rowblk; ch < T / 64; ch += G) {
        const int b = (ch * 64) / SEQ;
        __syncthreads();
        for (int d = tid; d < DM; d += 512) { tscale[d] = a.g2[d] * (1.0f + ada[b * ADA_N + 4 * DM + d]); tshift[d] = ada[b * ADA_N + 3 * DM + d]; }
        __syncthreads();
        norm_rows(a.out, h2, tscale, tshift, ch * 64, wave, lane);
    }
    LOCAL_BAR();

    { pg8::Gemm g{h2, Wfi, T, 2 * DFF, DM, DM, DM}; pg8::StaticOrder S; S.init(T, 2 * DFF, G, cidx); pg8::EpiSwiglu E{act, PLD}; pg8::gemm_phase(lds, g, S, E); }
    LOCAL_BAR();

    { pg8::Gemm g{act, Wfo, T, DM, DFF, PLD, DFF}; pg8::StaticOrder S; S.init(T, DM, G, cidx); pg8::EpiRes E{a.out, a.out, ada + 5 * DM, ADA_N}; pg8::gemm_phase(lds, g, S, E); }
    STAMP();
    if (PROBE_SEL >= 0) {
        if (tid == 0) { volatile LAS unsigned long long* st = (volatile LAS unsigned long long*)(lds + LDS_MISC + 64);
            const unsigned long long d = (st[PROBE_SEL + 1] - st[PROBE_SEL]) * PROBE_K, t0 = __builtin_amdgcn_s_memrealtime();
            while (__builtin_amdgcn_s_memrealtime() - t0 < d) __builtin_amdgcn_s_sleep(8); }
        __syncthreads();
    }
    { volatile LAS unsigned* lastf = (volatile LAS unsigned*)(lds + LDS_MISC + 48);
      asm volatile("s_waitcnt vmcnt(0)" ::: "memory");
      __syncthreads();
      if (tid == 0) *lastf = (xb_add(&g_ctl[8128], 1u) == (unsigned)G - 1u) ? 1u : 0u;
      __syncthreads();
      if (*lastf) { for (int i = tid; i < 8192; i += 512) __hip_atomic_store(&g_ctl[i], 0u, __ATOMIC_RELAXED, __HIP_MEMORY_SCOPE_AGENT); } }
}

constexpr int LDS_BYTES = 147456;
extern "C" void kernel_launch(void* const* d_in, const int* in_sizes, int n_in, void* d_out, int out_size, void* d_ws, size_t ws_size, hipStream_t stream) {
    static int grid = 0;
    if (grid == 0) {
        if (n_in != 19 || out_size != T * DM || ws_size < WS_END) { fprintf(stderr, "kernel_launch: unexpected problem (n_in %d out %d ws %zu)\n", n_in, out_size, ws_size); grid = -1; return; }
        int dev = 0, cus = 0, per_cu = 0;
        hipGetDevice(&dev); hipDeviceGetAttribute(&cus, hipDeviceAttributeMultiprocessorCount, dev);
        if (hipFuncSetAttribute((const void*)fwd_megakernel, hipFuncAttributeMaxDynamicSharedMemorySize, LDS_BYTES) != hipSuccess) { fprintf(stderr, "kernel_launch: hipFuncSetAttribute failed\n"); grid = -1; return; }
        if (hipOccupancyMaxActiveBlocksPerMultiprocessor(&per_cu, (const void*)fwd_megakernel, 512, LDS_BYTES) != hipSuccess || per_cu < 1) { fprintf(stderr, "kernel_launch: occupancy query failed (%d)\n", per_cu); per_cu = 1; }
        (void)hipGetLastError();
        grid = cus * (per_cu > 1 ? 1 : per_cu);
    }
    if (grid < 0) return;
    Args a{};
    a.x = (const float*)d_in[0]; a.c = (const float*)d_in[1]; a.pos = (const int*)d_in[2]; a.w_ada = (const float*)d_in[3]; a.b_ada = (const float*)d_in[4];
    a.g1 = (const float*)d_in[5]; a.g2 = (const float*)d_in[6]; a.w_in = (const float*)d_in[7]; a.g_ql = (const float*)d_in[8]; a.g_kvl = (const float*)d_in[9];
    a.w_uq = (const float*)d_in[10]; a.w_ukv = (const float*)d_in[11]; a.g_qh = (const float*)d_in[12]; a.g_kh = (const float*)d_in[13]; a.w_pa = (const float*)d_in[14];
    a.w_pb = (const float*)d_in[15]; a.w_out = (const float*)d_in[16]; a.w_fi = (const float*)d_in[17]; a.w_fo = (const float*)d_in[18];
    a.out = (float*)d_out; a.ws = (unsigned char*)d_ws;
    void* args[] = {&a};
    hipError_t e = hipLaunchCooperativeKernel((const void*)fwd_megakernel, dim3(grid), dim3(512), args, LDS_BYTES, stream);
    if (e != hipSuccess) fprintf(stderr, "kernel_launch: cooperative launch failed: %s (grid %d)\n", hipGetErrorString(e), grid);
}
```
